# Optimizing an MI355X kernel written in HIP

```python
import jax
import jax.numpy as jnp
from jax import lax
import numpy as np

D_MODEL = 1024
BATCH = 8
SEQ = 2048
DEPTH = 4

N_A_LAYERS = DEPTH // 2
N_B_LAYERS = DEPTH - N_A_LAYERS
A_HEADS = 8
A_HEAD_DIM = D_MODEL // A_HEADS
MOBA_BLOCK = 256
MOBA_TOPK = 3
MOBA_Q_CHUNK = 64
B_HEADS = 8
QK_NOPE_DIM = 128
QK_ROPE_DIM = 64
V_HEAD_DIM = D_MODEL // B_HEADS
Q_LORA_RANK = D_MODEL // 2
KV_LORA_RANK = D_MODEL // 4
MLA_Q_BLOCK = 128
D_FF = ((8 * D_MODEL // 3 + 255) // 256) * 256
ROPE_THETA = 10000.0
NORM_EPS = 1e-6
N_SUBLAYER_NORMS = 6

kernel_name = "yoco_moba_mla_macaron_sandwich"


def rms_norm(x, g):
    xf = x.astype(jnp.float32)
    y = xf * lax.rsqrt(jnp.mean(xf * xf, axis=-1, keepdims=True) + NORM_EPS)
    return (y * g.astype(jnp.float32)).astype(x.dtype)


def rope_tables(seq_len, dim):
    inv_freq = 1.0 / (ROPE_THETA ** (jnp.arange(0, dim, 2, dtype=jnp.float32) / dim))
    ang = jnp.arange(seq_len, dtype=jnp.float32)[:, None] * inv_freq[None, :]
    return jnp.cos(ang), jnp.sin(ang)


def apply_rope(x, cos, sin):
    half = x.shape[-1] // 2
    xf = x.astype(jnp.float32)
    x1, x2 = xf[..., :half], xf[..., half:]
    return jnp.concatenate([x1 * cos - x2 * sin, x1 * sin + x2 * cos], axis=-1).astype(x.dtype)


def swiglu(h, w1, w3, w2):
    return (jax.nn.silu(h @ w1) * (h @ w3)) @ w2


def moba_attention(q, k, v):
    bsz, nh, s_len, dh = q.shape
    nb = -(-s_len // MOBA_BLOCK)
    pad = nb * MOBA_BLOCK - s_len
    k_blk = jnp.pad(k, ((0, 0), (0, 0), (0, pad), (0, 0))).reshape(bsz, nh, nb, MOBA_BLOCK, dh)
    v_blk = jnp.pad(v, ((0, 0), (0, 0), (0, pad), (0, 0))).reshape(bsz, nh, nb, MOBA_BLOCK, dh)
    k_mean = jnp.mean(k_blk.astype(jnp.float32), axis=3)
    k_sel = min(MOBA_TOPK, nb - 1)
    scale = dh ** -0.5
    key_off = jnp.arange(MOBA_BLOCK)
    n_chunks = s_len // MOBA_Q_CHUNK
    gather = jax.vmap(jax.vmap(lambda blocks, idx: blocks[idx]))

    def chunk(c):
        start = c * MOBA_Q_CHUNK
        qc = lax.dynamic_slice_in_dim(q, start, MOBA_Q_CHUNK, axis=2)
        qpos = start + jnp.arange(MOBA_Q_CHUNK)
        own = start // MOBA_BLOCK
        logits = []
        top_i = None
        if k_sel > 0:
            gate = jnp.einsum('bhqd,bhnd->bhqn', qc.astype(jnp.float32), k_mean)
            gate = jnp.where(jnp.arange(nb) < own, gate, -jnp.inf)
            _, top_i = lax.top_k(gate, k_sel)
            valid = jnp.arange(k_sel) < own
            for s in range(k_sel):
                kg = gather(k_blk, top_i[..., s])
                l = jnp.einsum('bhqd,bhqkd->bhqk', qc, kg).astype(jnp.float32) * scale
                logits.append(jnp.where(valid[s], l, -jnp.inf))
        k_own = lax.dynamic_index_in_dim(k_blk, own, axis=2, keepdims=False)
        v_own = lax.dynamic_index_in_dim(v_blk, own, axis=2, keepdims=False)
        l_own = jnp.einsum('bhqd,bhkd->bhqk', qc, k_own).astype(jnp.float32) * scale
        causal = (own * MOBA_BLOCK + key_off)[None, :] <= qpos[:, None]
        logits.append(jnp.where(causal, l_own, -jnp.inf))
        p = jax.nn.softmax(jnp.concatenate(logits, axis=-1), axis=-1).astype(v.dtype)
        out = jnp.einsum('bhqk,bhkd->bhqd', p[..., k_sel * MOBA_BLOCK:], v_own)
        for s in range(k_sel):
            vg = gather(v_blk, top_i[..., s])
            out = out + jnp.einsum('bhqk,bhqkd->bhqd', p[..., s * MOBA_BLOCK:(s + 1) * MOBA_BLOCK], vg)
        return out

    outs = lax.map(chunk, jnp.arange(n_chunks))
    return outs.transpose(1, 2, 0, 3, 4).reshape(bsz, nh, s_len, dh)


def moba_mixer(h, w_qkv, w_o, cos_h, sin_h):
    bsz, s_len, _ = h.shape
    qkv = (h @ w_qkv).reshape(bsz, s_len, 3, A_HEADS, A_HEAD_DIM)
    q = apply_rope(qkv[:, :, 0], cos_h, sin_h).transpose(0, 2, 1, 3)
    k = apply_rope(qkv[:, :, 1], cos_h, sin_h).transpose(0, 2, 1, 3)
    v = qkv[:, :, 2].transpose(0, 2, 1, 3)
    o = moba_attention(q, k, v)
    return o.transpose(0, 2, 1, 3).reshape(bsz, s_len, A_HEADS * A_HEAD_DIM) @ w_o


def mla_shared_kv(h, kv_in_norm, w_dkv_kr, kv_norm, w_ukv, cos_r, sin_r):
    bsz, s_len, _ = h.shape
    ckr = rms_norm(h, kv_in_norm) @ w_dkv_kr
    c_kv = rms_norm(ckr[..., :KV_LORA_RANK], kv_norm)
    k_rope = apply_rope(ckr[..., KV_LORA_RANK:], cos_r, sin_r)
    kv = (c_kv @ w_ukv).reshape(bsz, s_len, B_HEADS, QK_NOPE_DIM + V_HEAD_DIM)
    return kv[..., :QK_NOPE_DIM], k_rope, kv[..., QK_NOPE_DIM:]


def mla_mixer(h, w_dq, q_norm, w_uq, w_o, k_nope, k_rope, v, cos_rh, sin_rh):
    bsz, s_len, _ = h.shape
    cq = rms_norm(h @ w_dq, q_norm)
    q = (cq @ w_uq).reshape(bsz, s_len, B_HEADS, QK_NOPE_DIM + QK_ROPE_DIM)
    q_nope = q[..., :QK_NOPE_DIM]
    q_rope = apply_rope(q[..., QK_NOPE_DIM:], cos_rh, sin_rh)
    scale = (QK_NOPE_DIM + QK_ROPE_DIM) ** -0.5
    kpos = jnp.arange(s_len)

    def block(i):
        s0 = i * MLA_Q_BLOCK
        qn = lax.dynamic_slice_in_dim(q_nope, s0, MLA_Q_BLOCK, axis=1)
        qr = lax.dynamic_slice_in_dim(q_rope, s0, MLA_Q_BLOCK, axis=1)
        logits = (jnp.einsum('bqhd,bkhd->bhqk', qn, k_nope)
                  + jnp.einsum('bqhd,bkd->bhqk', qr, k_rope)).astype(jnp.float32) * scale
        qpos = s0 + jnp.arange(MLA_Q_BLOCK)
        logits = jnp.where(kpos[None, :] <= qpos[:, None], logits, -jnp.inf)
        p = jax.nn.softmax(logits, axis=-1).astype(v.dtype)
        return jnp.einsum('bhqk,bkhd->bqhd', p, v)

    o = lax.map(block, jnp.arange(s_len // MLA_Q_BLOCK))
    o = o.transpose(1, 0, 2, 3, 4).reshape(bsz, s_len, B_HEADS * V_HEAD_DIM)
    return o @ w_o


def setup_inputs(seed: int = 0) -> dict:
    key = jax.random.key(seed)
    ks = jax.random.split(key, 20)

    def w(k, shape, fan_in):
        return jax.random.normal(k, shape, jnp.float32) * fan_in ** -0.5

    def gain(k, shape):
        return 1.0 + 0.02 * jax.random.normal(k, shape, jnp.float32)

    return {
        'x': jax.random.normal(ks[0], (BATCH, SEQ, D_MODEL), jnp.float32),
        'norm_gains': gain(ks[1], (DEPTH, N_SUBLAYER_NORMS, D_MODEL)),
        'ffn_w1': w(ks[2], (DEPTH, 2, D_MODEL, D_FF), D_MODEL),
        'ffn_w3': w(ks[3], (DEPTH, 2, D_MODEL, D_FF), D_MODEL),
        'ffn_w2': w(ks[4], (DEPTH, 2, D_FF, D_MODEL), D_FF),
        'moba_w_qkv': w(ks[5], (N_A_LAYERS, D_MODEL, 3 * A_HEADS * A_HEAD_DIM), D_MODEL),
        'moba_w_o': w(ks[6], (N_A_LAYERS, A_HEADS * A_HEAD_DIM, D_MODEL), A_HEADS * A_HEAD_DIM),
        'mla_w_dq': w(ks[7], (N_B_LAYERS, D_MODEL, Q_LORA_RANK), D_MODEL),
        'mla_q_norm': gain(ks[8], (N_B_LAYERS, Q_LORA_RANK)),
        'mla_w_uq': w(ks[9], (N_B_LAYERS, Q_LORA_RANK, B_HEADS * (QK_NOPE_DIM + QK_ROPE_DIM)), Q_LORA_RANK),
        'mla_w_o': w(ks[10], (N_B_LAYERS, B_HEADS * V_HEAD_DIM, D_MODEL), B_HEADS * V_HEAD_DIM),
        'kv_in_norm': gain(ks[11], (D_MODEL,)),
        'w_dkv_kr': w(ks[12], (D_MODEL, KV_LORA_RANK + QK_ROPE_DIM), D_MODEL),
        'kv_norm': gain(ks[13], (KV_LORA_RANK,)),
        'w_ukv': w(ks[14], (KV_LORA_RANK, B_HEADS * (QK_NOPE_DIM + V_HEAD_DIM)), KV_LORA_RANK),
    }


def reference(x, norm_gains, ffn_w1, ffn_w3, ffn_w2, moba_w_qkv, moba_w_o, mla_w_dq, mla_q_norm,
              mla_w_uq, mla_w_o, kv_in_norm, w_dkv_kr, kv_norm, w_ukv):
    s_len = x.shape[1]
    cos_a, sin_a = rope_tables(s_len, A_HEAD_DIM)
    cos_r, sin_r = rope_tables(s_len, QK_ROPE_DIM)
    k_nope = k_rope = v_sh = None
    for l in range(DEPTH):
        g = norm_gains[l]
        x = x + 0.5 * rms_norm(swiglu(rms_norm(x, g[0]), ffn_w1[l, 0], ffn_w3[l, 0], ffn_w2[l, 0]), g[1])
        hn = rms_norm(x, g[2])
        if l < N_A_LAYERS:
            mix = moba_mixer(hn, moba_w_qkv[l], moba_w_o[l], cos_a[:, None, :], sin_a[:, None, :])
        else:
            j = l - N_A_LAYERS
            mix = mla_mixer(hn, mla_w_dq[j], mla_q_norm[j], mla_w_uq[j], mla_w_o[j],
                            k_nope, k_rope, v_sh, cos_r[:, None, :], sin_r[:, None, :])
        x = x + rms_norm(mix, g[3])
        x = x + 0.5 * rms_norm(swiglu(rms_norm(x, g[4]), ffn_w1[l, 1], ffn_w3[l, 1], ffn_w2[l, 1]), g[5])
        if l == N_A_LAYERS - 1:
            k_nope, k_rope, v_sh = mla_shared_kv(x, kv_in_norm, w_dkv_kr, kv_norm, w_ukv, cos_r, sin_r)
    return x
```

```cpp
#include <hip/hip_runtime.h>
#include <cstdio>
#include <cstdint>
namespace pg8 {
#define PG8_LAS __attribute__((address_space(3)))
typedef unsigned short bf16_t;
typedef short bf16x8 __attribute__((ext_vector_type(8)));
typedef float f32x4 __attribute__((ext_vector_type(4)));
typedef unsigned u32x4 __attribute__((ext_vector_type(4)));
constexpr int BM = 256, BK = 64, HALF = 128, HTB = HALF * BK * 2  , STAGE_BYTES = 8 * HTB, NXCD = 8, WGM = 8;

__host__ __device__ __forceinline__ int lds_byte(int r, int c) { const int st = (r >> 4) * 2 + (c >> 5), rr = r & 15, cc = c & 31, ob = rr * 64 + cc * 2; return st * 1024 + (ob ^ (((ob >> 9) & 1) << 5)); }
__host__ __device__ __forceinline__ void stage_rc(int b, int& R, int& C) { const int st = b / 1024, sb = b % 1024, swz = sb ^ (((sb >> 9) & 1) << 5); R = (st >> 1) * 16 + swz / 64; C = (st & 1) * 32 + (swz % 64) / 2; }
__host__ __device__ __forceinline__ int perm32(int rho) { const int n = rho >> 4, i = rho & 15; return 8 * (i >> 2) + 4 * n + (i & 3); }

struct Unit { int pm, pn; };
struct Gemm { const bf16_t* A; const bf16_t* Bt; int M, N, K; };

struct StaticOrder {
    int nM, nN, nwg, G, c;
    __host__ __device__ void init(int M, int N, int G_, int c_) { nM = M / BM; nN = N / BM; nwg = nM * nN; G = G_; c = c_; }
    __host__ __device__ bool next(int i, Unit& u) const {
        const long L = (long)i * G + c; if (L >= nwg) return false;
        int wgid = (int)L; { const int q = nwg / NXCD, r = nwg % NXCD, xcd = wgid % NXCD, off = wgid / NXCD; wgid = (xcd < r ? xcd * (q + 1) : r * (q + 1) + (xcd - r) * q) + off; }
        const int nig = WGM * nN, gid = wgid / nig, fm = gid * WGM, gsz = (nM - fm) < WGM ? (nM - fm) : WGM;
        u.pm = fm + ((wgid % nig) % gsz); u.pn = (wgid % nig) / gsz; return true;
    }
    __device__ __forceinline__ void a_ready(const Unit&) const {}
    __device__ __forceinline__ void done(const Unit&) const {}
};

__device__ __forceinline__ unsigned cvt_pk_bf16(float lo, float hi) { unsigned r; asm volatile("v_cvt_pk_bf16_f32 %0, %1, %2" : "=v"(r) : "v"(lo), "v"(hi)); return r; }
typedef float f32x2 __attribute__((ext_vector_type(2)));
__device__ __forceinline__ u32x4 pack8bf(const f32x4 v0, const f32x4 v1) { u32x4 w; w.x = cvt_pk_bf16(v0[0], v0[1]); w.y = cvt_pk_bf16(v0[2], v0[3]); w.z = cvt_pk_bf16(v1[0], v1[1]); w.w = cvt_pk_bf16(v1[2], v1[3]); return w; }
struct EpiPlain {
    static constexpr bool PERM = true, AFTER_DRAIN = false;
    bf16_t* O; int ldc;
    __device__ __forceinline__ void operator()(const f32x4 (&acc)[2][2][4][2], const Unit& u, int wr, int wc, int fr, int fq) const {
        const int row0 = u.pm * BM + wr * 64 + fr, col0 = u.pn * BM + wc * 32 + 8 * fq;
#pragma unroll
        for (int ai = 0; ai < 2; ++ai)
#pragma unroll
            for (int m = 0; m < 4; ++m) { bf16_t* rowp = O + (size_t)(row0 + ai * HALF + m * 16) * ldc + col0;
#pragma unroll
                for (int bj = 0; bj < 2; ++bj) *(u32x4*)(rowp + bj * HALF) = pack8bf(acc[ai][bj][m][0], acc[ai][bj][m][1]); }
    }
};
struct EpiSwiGLU {
    static constexpr bool PERM = true, AFTER_DRAIN = false;
    bf16_t* O; int ldc;
    __device__ __forceinline__ void operator()(const f32x4 (&acc)[2][2][4][2], const Unit& u, int wr, int wc, int fr, int fq) const {
        const int row0 = u.pm * BM + wr * 64 + fr, col0 = u.pn * HALF + wc * 32 + 8 * fq;
#pragma unroll
        for (int ai = 0; ai < 2; ++ai)
#pragma unroll
            for (int m = 0; m < 4; ++m) { bf16_t* rowp = O + (size_t)(row0 + ai * HALF + m * 16) * ldc + col0; f32x4 h[2];
#pragma unroll
                for (int n = 0; n < 2; ++n)
#pragma unroll
                    for (int j = 0; j < 4; ++j) { const float a = acc[ai][0][m][n][j], b = acc[ai][1][m][n][j];
                        h[n][j] = a * b * __builtin_amdgcn_rcpf(1.0f + __builtin_amdgcn_exp2f(-1.4426950408889634f * a)); }
                *(u32x4*)rowp = pack8bf(h[0], h[1]); }
    }
};
struct EpiQKV {
    static constexpr bool PERM = true, AFTER_DRAIN = false;
    bf16_t* Q; size_t kv_stride; const float* cs; const float* sn;
    __device__ __forceinline__ void operator()(const f32x4 (&acc)[2][2][4][2], const Unit& u, int wr, int wc, int fr, int fq) const {
        const int which = u.pn >> 2, hp = u.pn & 3, head = 2 * hp + (wc >> 1), d0 = 32 * (wc & 1) + 8 * fq;
        bf16_t* base = Q + (size_t)which * kv_stride;
#pragma unroll
        for (int ai = 0; ai < 2; ++ai)
#pragma unroll
            for (int m = 0; m < 4; ++m) { const int row = u.pm * BM + ai * HALF + wr * 64 + m * 16 + fr, b = row >> 11, s = row & 2047;
                bf16_t* dst = base + ((size_t)((b * 8 + head) * 2048 + s)) * 128 + d0;
                f32x4 x1[2] = {acc[ai][0][m][0], acc[ai][0][m][1]}, x2[2] = {acc[ai][1][m][0], acc[ai][1][m][1]};
                if (which < 2) {
#pragma unroll
                    for (int n = 0; n < 2; ++n) { const f32x4 c = *(const f32x4*)(cs + s * 64 + d0 + 4 * n), sv = *(const f32x4*)(sn + s * 64 + d0 + 4 * n);
                        const f32x4 a = x1[n], bb = x2[n]; x1[n] = a * c - bb * sv; x2[n] = a * sv + bb * c; } }
                *(u32x4*)dst = pack8bf(x1[0], x1[1]); *(u32x4*)(dst + 64) = pack8bf(x2[0], x2[1]); }
    }
};
struct EpiUQ {
    static constexpr bool PERM = true, AFTER_DRAIN = false;
    bf16_t* Q; const float* cs; const float* sn;
    __device__ __forceinline__ void operator()(const f32x4 (&acc)[2][2][4][2], const Unit& u, int wr, int wc, int fr, int fq) const {
#pragma unroll
        for (int ai = 0; ai < 2; ++ai)
#pragma unroll
            for (int m = 0; m < 4; ++m) { const int row = u.pm * BM + ai * HALF + wr * 64 + m * 16 + fr, b = row >> 11, s = row & 2047;
                if (u.pn < 4) {
#pragma unroll
                    for (int bj = 0; bj < 2; ++bj) { bf16_t* dst = Q + ((size_t)((b * 8 + 2 * u.pn + bj) * 2048 + s)) * 192 + 32 * wc + 8 * fq;
                        *(u32x4*)dst = pack8bf(acc[ai][bj][m][0], acc[ai][bj][m][1]); }
                } else {
                    bf16_t* dst = Q + ((size_t)((b * 8 + 4 * (u.pn - 4) + wc) * 2048 + s)) * 192 + 128 + 8 * fq;
                    f32x4 x1[2] = {acc[ai][0][m][0], acc[ai][0][m][1]}, x2[2] = {acc[ai][1][m][0], acc[ai][1][m][1]};
#pragma unroll
                    for (int n = 0; n < 2; ++n) { const f32x4 c = *(const f32x4*)(cs + s * 32 + 8 * fq + 4 * n), sv = *(const f32x4*)(sn + s * 32 + 8 * fq + 4 * n);
                        const f32x4 a = x1[n], bb = x2[n]; x1[n] = a * c - bb * sv; x2[n] = a * sv + bb * c; }
                    *(u32x4*)dst = pack8bf(x1[0], x1[1]); *(u32x4*)(dst + 32) = pack8bf(x2[0], x2[1]); } }
    }
};
struct EpiUKV {
    static constexpr bool PERM = true, AFTER_DRAIN = false;
    bf16_t* KN; bf16_t* V;
    __device__ __forceinline__ void operator()(const f32x4 (&acc)[2][2][4][2], const Unit& u, int wr, int wc, int fr, int fq) const {
#pragma unroll
        for (int ai = 0; ai < 2; ++ai)
#pragma unroll
            for (int m = 0; m < 4; ++m) { const int row = u.pm * BM + ai * HALF + wr * 64 + m * 16 + fr, b = row >> 11, s = row & 2047;
                const size_t off = ((size_t)((b * 8 + u.pn) * 2048 + s)) * 128 + 32 * wc + 8 * fq;
                *(u32x4*)(KN + off) = pack8bf(acc[ai][0][m][0], acc[ai][0][m][1]); *(u32x4*)(V + off) = pack8bf(acc[ai][1][m][0], acc[ai][1][m][1]); }
    }
};

template <class Epi, class Sched, bool ALIGN_EPI = false, bool SP2 = false>
__device__ __forceinline__ void gemm_phase(PG8_LAS unsigned char* lds, const Gemm g, const Sched& S, const Epi& E) {
    int tid = threadIdx.x; asm volatile("" : "+v"(tid));
    const int wid = __builtin_amdgcn_readfirstlane(tid >> 6), lane = tid & 63, wr = wid >> 2, wc = wid & 3, fr = lane & 15, fq = lane >> 4;
    const int K = g.K, nt = K / BK;
    unsigned voffA[2], voffB[2];
#pragma unroll
    for (int i = 0; i < 2; ++i) { int R, C; stage_rc(tid * 16 + i * 8192, R, C); const int Rb = Epi::PERM ? ((R & ~31) + perm32(R & 31)) : R;
        voffA[i] = (unsigned)(R * K + C) * 2u; voffB[i] = (unsigned)(Rb * K + C) * 2u; }
    const size_t kstep = (size_t)(BK * 2);
    const size_t hstep = (size_t)HALF * K * 2;
    const size_t tstep = 2 * hstep;
    const unsigned ldsw = (unsigned)wid * 1024u;
    const int aoff = lds_byte(wr * 64 + fr, fq * 8), boff = lds_byte(wc * 32 + fr, fq * 8);
#define PG8_SA(b, h) (((b) * 2 + (h)) * HTB)
#define PG8_SB(b, h) ((4 + (b) * 2 + (h)) * HTB)
#define PG8_STAGE(bufoff, gbase, voff) do { _Pragma("unroll") for (int _i = 0; _i < 2; ++_i) \
        __builtin_amdgcn_global_load_lds((const unsigned*)((const char*)(gbase) + (voff)[_i]), (PG8_LAS unsigned*)(lds + (bufoff) + ldsw + _i * 8192), 16, 0, 0); } while (0)
#define PG8_LDA(dst, b, h) do { _Pragma("unroll") for (int m = 0; m < 4; ++m) _Pragma("unroll") for (int k = 0; k < 2; ++k) dst[m][k] = *(const PG8_LAS bf16x8*)(lds + PG8_SA(b, h) + aoff + m * 2048 + k * 1024); } while (0)
#define PG8_LDB(dst, b, h) do { _Pragma("unroll") for (int n = 0; n < 2; ++n) _Pragma("unroll") for (int k = 0; k < 2; ++k) dst[n][k] = *(const PG8_LAS bf16x8*)(lds + PG8_SB(b, h) + boff + n * 2048 + k * 1024); } while (0)
#define PG8_MMA(ai, bj, At, Bt) do { __builtin_amdgcn_s_setprio(1); _Pragma("unroll") for (int m = 0; m < 4; ++m) _Pragma("unroll") for (int n = 0; n < 2; ++n) _Pragma("unroll") for (int k = 0; k < 2; ++k) \
        acc[ai][bj][m][n] = __builtin_amdgcn_mfma_f32_16x16x32_bf16(Bt[n][k], At[m][k], acc[ai][bj][m][n], 0, 0, 0); __builtin_amdgcn_s_setprio(0); } while (0)
#define PG8_WAIT_V(n) asm volatile("s_waitcnt vmcnt(" #n ")" ::: "memory")
#define PG8_WAIT_L(n) asm volatile("s_waitcnt lgkmcnt(" #n ")" ::: "memory")
#define PG8_BAR __builtin_amdgcn_s_barrier()
#define PG8_SCHED __builtin_amdgcn_sched_barrier(0)
    Unit cur, nxt; int ui = 0;
    if (!S.next(0, cur)) return;
    f32x4 acc[2][2][4][2];
#pragma unroll
    for (int a = 0; a < 2; ++a)
#pragma unroll
        for (int b = 0; b < 2; ++b)
#pragma unroll
            for (int m = 0; m < 4; ++m)
#pragma unroll
                for (int n = 0; n < 2; ++n) acc[a][b][m][n] = (f32x4){0.f, 0.f, 0.f, 0.f};
    bf16x8 At[4][2], B0[2][2], B1[2][2];
    const char* cA = (const char*)g.A + (size_t)cur.pm * tstep; const char* cB = (const char*)g.Bt + (size_t)cur.pn * tstep;
    S.a_ready(cur);
    if constexpr (SP2) {
        PG8_STAGE(PG8_SB(0, 0), cB, voffB); PG8_STAGE(PG8_SB(0, 1), cB + hstep, voffB); PG8_STAGE(PG8_SA(0, 0), cA, voffA); PG8_STAGE(PG8_SA(0, 1), cA + hstep, voffA);
        if (wr == 1) PG8_BAR;
        PG8_WAIT_V(2); PG8_BAR;
        PG8_STAGE(PG8_SB(1, 0), cB + kstep, voffB); PG8_STAGE(PG8_SA(1, 0), cA + kstep, voffA); PG8_STAGE(PG8_SB(1, 1), cB + hstep + kstep, voffB);
        PG8_WAIT_V(6); PG8_BAR;
    } else {
        PG8_STAGE(PG8_SB(0, 0), cB, voffB); PG8_STAGE(PG8_SA(0, 0), cA, voffA); PG8_STAGE(PG8_SB(0, 1), cB + hstep, voffB); PG8_STAGE(PG8_SA(0, 1), cA + hstep, voffA);
        if (wr == 1) PG8_BAR;
        PG8_WAIT_V(4); PG8_BAR;
        PG8_STAGE(PG8_SB(1, 0), cB + kstep, voffB); PG8_STAGE(PG8_SA(1, 0), cA + kstep, voffA); PG8_STAGE(PG8_SB(1, 1), cB + hstep + kstep, voffB);
        PG8_WAIT_V(6); PG8_BAR;
    }
    for (;;) {
        const bool has_next = S.next(ui + 1, nxt);
        const char* nA = has_next ? (const char*)g.A + (size_t)nxt.pm * tstep : cA; const char* nB = has_next ? (const char*)g.Bt + (size_t)nxt.pn * tstep : cB;
        for (int t = 0; t < nt; t += 2) {
            const bool last = (t == nt - 2);
            const char* a1 = cA + (size_t)(t + 1) * kstep;
            const char* a2 = last ? nA : cA + (size_t)(t + 2) * kstep; const char* b2 = last ? nB : cB + (size_t)(t + 2) * kstep;
            const char* a3 = a2 + kstep; const char* b3 = b2 + kstep;
            if (last && has_next) S.a_ready(nxt);
            if constexpr (SP2) {
            PG8_LDB(B0, 0, 0); PG8_LDB(B1, 0, 1); PG8_SCHED; PG8_LDA(At, 0, 0); PG8_STAGE(PG8_SA(1, 1), a1 + hstep, voffA);
            PG8_WAIT_V(8); PG8_WAIT_L(0); PG8_BAR; PG8_MMA(0, 0, At, B0); PG8_MMA(0, 1, At, B1); PG8_BAR; PG8_SCHED;
            PG8_LDA(At, 0, 1); PG8_STAGE(PG8_SB(0, 0), b2, voffB); PG8_STAGE(PG8_SB(0, 1), b2 + hstep, voffB); PG8_STAGE(PG8_SA(0, 0), a2, voffA);
            PG8_WAIT_V(8); PG8_WAIT_L(0); PG8_BAR; PG8_MMA(1, 0, At, B0); PG8_MMA(1, 1, At, B1); PG8_BAR; PG8_SCHED;
            PG8_LDB(B0, 1, 0); PG8_LDB(B1, 1, 1); PG8_SCHED; PG8_LDA(At, 1, 0); PG8_STAGE(PG8_SA(0, 1), a2 + hstep, voffA);
            PG8_WAIT_V(8); PG8_WAIT_L(0); PG8_BAR; PG8_MMA(0, 0, At, B0); PG8_MMA(0, 1, At, B1); PG8_BAR; PG8_SCHED;
            PG8_LDA(At, 1, 1); PG8_STAGE(PG8_SB(1, 0), b3, voffB); PG8_STAGE(PG8_SB(1, 1), b3 + hstep, voffB); PG8_STAGE(PG8_SA(1, 0), a3, voffA);
            PG8_WAIT_V(8); PG8_WAIT_L(0); PG8_BAR; PG8_MMA(1, 0, At, B0); PG8_MMA(1, 1, At, B1); PG8_BAR; PG8_SCHED;
            } else {
            PG8_LDB(B0, 0, 0); PG8_SCHED; PG8_LDA(At, 0, 0); PG8_STAGE(PG8_SA(1, 1), a1 + hstep, voffA);
            PG8_WAIT_L(8); PG8_BAR; PG8_WAIT_L(0); PG8_MMA(0, 0, At, B0); PG8_BAR; PG8_SCHED;
            PG8_LDB(B1, 0, 1); PG8_STAGE(PG8_SB(0, 0), b2, voffB);
            PG8_BAR; PG8_WAIT_L(0); PG8_MMA(0, 1, At, B1); PG8_BAR;
            PG8_LDA(At, 0, 1); PG8_STAGE(PG8_SA(0, 0), a2, voffA);
            PG8_BAR; PG8_WAIT_L(0); PG8_MMA(1, 0, At, B0); PG8_BAR; PG8_SCHED;
            PG8_STAGE(PG8_SB(0, 1), b2 + hstep, voffB);
            PG8_WAIT_V(6); PG8_BAR; PG8_MMA(1, 1, At, B1); PG8_BAR;
            PG8_LDB(B0, 1, 0); PG8_SCHED; PG8_LDA(At, 1, 0); PG8_STAGE(PG8_SA(0, 1), a2 + hstep, voffA);
            PG8_WAIT_L(8); PG8_BAR; PG8_WAIT_L(0); PG8_MMA(0, 0, At, B0); PG8_BAR; PG8_SCHED;
            PG8_LDB(B1, 1, 1); PG8_STAGE(PG8_SB(1, 0), b3, voffB);
            PG8_BAR; PG8_WAIT_L(0); PG8_MMA(0, 1, At, B1); PG8_BAR;
            PG8_LDA(At, 1, 1); PG8_STAGE(PG8_SA(1, 0), a3, voffA);
            PG8_BAR; PG8_WAIT_L(0); PG8_MMA(1, 0, At, B0); PG8_BAR; PG8_SCHED;
            PG8_STAGE(PG8_SB(1, 1), b3 + hstep, voffB);
            PG8_WAIT_V(6); PG8_BAR; PG8_MMA(1, 1, At, B1); PG8_BAR;
            }
        }
        if constexpr (ALIGN_EPI) { if (wr == 0) PG8_BAR; }
        if constexpr (!Epi::AFTER_DRAIN) { E(acc, cur, wr, wc, fr, fq); S.done(cur); }
        if (!has_next) break;
#pragma unroll
        for (int a = 0; a < 2; ++a)
#pragma unroll
            for (int b = 0; b < 2; ++b)
#pragma unroll
                for (int m = 0; m < 4; ++m)
#pragma unroll
                    for (int n = 0; n < 2; ++n) acc[a][b][m][n] = (f32x4){0.f, 0.f, 0.f, 0.f};
        cur = nxt; cA = nA; cB = nB; ++ui;
        if constexpr (ALIGN_EPI) { if (wr == 1) PG8_BAR; }
    }
    PG8_WAIT_V(0);
    if constexpr (!ALIGN_EPI) { if (wr == 0) PG8_BAR; }
    PG8_BAR;
    if constexpr (Epi::AFTER_DRAIN) { E.fused(acc, cur, wr, wc, fr, fq, lds, wid, lane); S.done(cur); }
#undef PG8_SA
#undef PG8_SB
#undef PG8_STAGE
#undef PG8_LDA
#undef PG8_LDB
#undef PG8_MMA
#undef PG8_WAIT_V
#undef PG8_WAIT_L
#undef PG8_BAR
#undef PG8_SCHED
}
}
#define GAS __attribute__((address_space(1)))
#define LAS __attribute__((address_space(3)))
typedef unsigned short bf16;
typedef unsigned v4u __attribute__((ext_vector_type(4)));
typedef float f32x4 __attribute__((ext_vector_type(4)));
typedef short bf16x8 __attribute__((ext_vector_type(8)));
typedef GAS unsigned gu32;
typedef GAS unsigned long long gu64;
#define RLX_AGENT __ATOMIC_RELAXED, __HIP_MEMORY_SCOPE_AGENT
#define LDS_WAIT() asm volatile("s_waitcnt lgkmcnt(0)" ::: "memory")
#define VM_WAIT() asm volatile("s_waitcnt vmcnt(0)" ::: "memory")
__device__ __forceinline__ unsigned long long rt() { return __builtin_amdgcn_s_memrealtime(); }
__device__ __forceinline__ unsigned f2bf(float f) { unsigned u = __builtin_bit_cast(unsigned, f); return (u + 0x7fffu + ((u >> 16) & 1u)) >> 16; }
__device__ __forceinline__ unsigned pk2(float lo, float hi) { return f2bf(lo) | (f2bf(hi) << 16); }

#define XB_TMO      128
#define XB_XCNT(j)  (256  + 64 * (j))
#define XB_XSUB(j)  (1280 + 64 * (j))
#define XB_XGEN(j)  (2304 + 64 * (j))
#define XB_TOP      3328
#define XB_TOPGEN   3392
#define XCD_BAR_WORDS 3456
#define XB_SPIN_CAP (1u << 18)

__device__ __forceinline__ unsigned xb_ld(unsigned* p)              { return __hip_atomic_load(p, __ATOMIC_RELAXED, __HIP_MEMORY_SCOPE_AGENT); }
__device__ __forceinline__ unsigned xb_add(unsigned* p, unsigned v) { return __hip_atomic_fetch_add(p, v, __ATOMIC_RELAXED, __HIP_MEMORY_SCOPE_AGENT); }
__device__ __forceinline__ unsigned xb_xcc_id() { return (unsigned)__builtin_amdgcn_s_getreg((3 << 11) | 20) & 0xFu; }
#define XB_SPIN(cond, bar) do { unsigned _sp = 0; while (cond) { __builtin_amdgcn_s_sleep(1); \
    if ((++_sp & 255u) == 0u) { if (xb_ld(&(bar)[XB_TMO])) break; if (_sp > XB_SPIN_CAP) { atomicAdd(&(bar)[XB_TMO], 1u); break; } } } } while (0)

struct XcdBarrier {
    unsigned* bar; unsigned x;
    volatile LAS unsigned* st;
};

__device__ __forceinline__ XcdBarrier xcd_barrier_post(unsigned* bar, volatile LAS unsigned* st) {
    XcdBarrier b; b.bar = bar; b.x = xb_xcc_id(); b.st = st;
    if (threadIdx.x == 0) (void)xb_add(&bar[XB_XCNT(b.x)], 1u);
    return b;
}
__device__ __forceinline__ void xcd_barrier_complete(unsigned* bar, unsigned x, unsigned& nloc, unsigned& nx) {
    const unsigned G = gridDim.x * gridDim.y * gridDim.z;
    unsigned sum, cnt, mine, sp = 0u;
    for (;;) {
        sum = 0u; cnt = 0u; mine = 0u;
#pragma unroll
        for (unsigned j = 0; j < 16; ++j) { const unsigned c = xb_ld(&bar[XB_XCNT(j)]); sum += c; cnt += (c > 0u) ? 1u : 0u; mine = (j == x) ? c : mine; }
        if (sum == G) break;
        __builtin_amdgcn_s_sleep(1);
        if ((++sp & 255u) == 0u) { if (xb_ld(&bar[XB_TMO])) break; if (sp > XB_SPIN_CAP) { atomicAdd(&bar[XB_TMO], 1u); break; } }
    }
    nloc = mine > 0u ? mine : 1u; nx = cnt > 0u ? cnt : 1u;
}

__device__ __forceinline__ void xcd_barrier(const XcdBarrier& b) {
    asm volatile("s_waitcnt vmcnt(0)" ::: "memory");
    __syncthreads();
    if (threadIdx.x == 0) {
        unsigned* bar = b.bar;
        __builtin_amdgcn_s_waitcnt(0);
        unsigned nloc = b.st[0], nx = b.st[1];
        if (nloc == 0u) { xcd_barrier_complete(bar, b.x, nloc, nx); b.st[0] = nloc; b.st[1] = nx; }
        const unsigned old = xb_add(&bar[XB_XSUB(b.x)], 1u);
        const unsigned gen = old / nloc;
        if (old + 1u == (gen + 1u) * nloc) {
            __builtin_amdgcn_fence(__ATOMIC_RELEASE, "agent");
            asm volatile("s_waitcnt vmcnt(0)" ::: "memory");
            const unsigned og = xb_add(&bar[XB_TOP], 1u);
            const unsigned tg = og / nx;
            if (og + 1u == (tg + 1u) * nx) xb_add(&bar[XB_TOPGEN], 1u);
            else XB_SPIN(xb_ld(&bar[XB_TOPGEN]) == tg, bar);
            __builtin_amdgcn_fence(__ATOMIC_ACQUIRE, "agent");
            xb_add(&bar[XB_XGEN(b.x)], 1u);
            asm volatile("s_waitcnt vmcnt(0)" ::: "memory");
        } else {
            XB_SPIN(xb_ld(&bar[XB_XGEN(b.x)]) == gen, bar);
            __builtin_amdgcn_fence(__ATOMIC_ACQUIRE, "agent");
            asm volatile("s_waitcnt vmcnt(0)" ::: "memory");
        }
    }
    __syncthreads();
}


constexpr int NWAVES = 8;
constexpr int BATCH = 8, SEQ = 2048, D = 1024, M = BATCH * SEQ, FF = 2816, NLAYER = 4, NH = 8;
constexpr int QL = 512, KVL = 256, QKD = 192;
constexpr float EPS = 1e-6f;

constexpr size_t MiB = 1u << 20;
constexpr size_t WS_CTL = 0, CTL_ZERO_BYTES = 1 * MiB;
constexpr size_t WS_COSA = 1 * MiB, WS_SINA = WS_COSA + 512 * 1024, WS_COSR = 2 * MiB, WS_SINR = WS_COSR + 256 * 1024, WS_KMEAN = 3 * MiB;
constexpr size_t FFN_W_BYTES = 16 * MiB + 512 * 1024, UP_W_BYTES = 11 * MiB;
__host__ __device__ constexpr size_t ws_wffn(int l, int s) { return (l < 2 ? 4 * MiB + (size_t)(l * 2 + s) * FFN_W_BYTES : 86 * MiB + (size_t)((l - 2) * 2 + s) * FFN_W_BYTES); }
__host__ __device__ constexpr size_t ws_wmoba(int l) { return 70 * MiB + (size_t)l * 8 * MiB; }
__host__ __device__ constexpr size_t ws_wmla(int j) { return 152 * MiB + (size_t)j * (4 * MiB + 512 * 1024); }
constexpr size_t WS_WDKV = 161 * MiB, WS_WUKV = 162 * MiB;
constexpr size_t WS_KN = 4 * MiB, WS_VS = 36 * MiB, WS_KR = 68 * MiB;
constexpr size_t WS_XN = 163 * MiB, WS_Y = 195 * MiB, WS_BIG = 227 * MiB, WS_END = 323 * MiB;
constexpr int CW_TMO = 0, CW_CODE = 1, CW_BAR = 4096;

constexpr int RING_OFF = 0, RING_BYTES = 131072;
constexpr int LDSCTL_OFF = RING_BYTES, MISC_OFF = LDSCTL_OFF + 320;
constexpr int LDS_BYTES = 147456;

struct Frame {
    LAS unsigned char* lds;
    volatile LAS unsigned* MISC;
    gu32* ctl;
    int tid, lane, wave;
    int vcu, G, bx;
};
__device__ __forceinline__ Frame mk_frame(LAS unsigned char* lds, unsigned char* ws) {
    Frame F; int tid = threadIdx.x; asm volatile("" : "+v"(tid)); int bx = blockIdx.x; asm volatile("" : "+s"(bx)); int G = gridDim.x; asm volatile("" : "+s"(G));
    F.lds = lds; F.MISC = (volatile LAS unsigned*)(lds + MISC_OFF); F.ctl = (gu32*)(ws + WS_CTL);
    F.tid = tid; F.lane = tid & 63; F.wave = __builtin_amdgcn_readfirstlane(tid >> 6);
    F.G = G; F.bx = bx; F.vcu = (G % 8 == 0) ? (bx % 8) * (G / 8) + bx / 8 : bx;
    return F;
}

__device__ __forceinline__ float wave_sum(float v) {
#pragma unroll
    for (int o = 1; o < 64; o <<= 1) v += __shfl_xor(v, o);
    return v;
}
__device__ __forceinline__ float bf2f(unsigned short b) { return __builtin_bit_cast(float, ((unsigned)b) << 16); }

__device__ __forceinline__ void conv_item(const float* src, int ldw, const float* gain, bf16* dst  , int K, int k0, LAS float* scr, int lane) {
    if (src) {
#pragma unroll 8
        for (int i = 0; i < 32; ++i) { const int kk = 2 * i + (lane >> 5); float v = src[(size_t)(k0 + kk) * ldw + (lane & 31)]; if (gain) v *= gain[k0 + kk]; scr[kk * 33 + (lane & 31)] = v; }
    } else {
#pragma unroll 8
        for (int i = 0; i < 32; ++i) { const int kk = 2 * i + (lane >> 5); scr[kk * 33 + (lane & 31)] = 0.f; }
    }
    LDS_WAIT(); asm volatile("" ::: "memory");
    const int c = lane & 7;
#pragma unroll
    for (int j = 0; j < 4; ++j) { const int n = (lane >> 3) + 8 * j; const LAS float* s = scr + (8 * c) * 33 + n;
        v4u o; o.x = pk2(s[0 * 33], s[1 * 33]); o.y = pk2(s[2 * 33], s[3 * 33]); o.z = pk2(s[4 * 33], s[5 * 33]); o.w = pk2(s[6 * 33], s[7 * 33]);
        *(GAS v4u*)(dst + (size_t)n * K + k0 + 8 * c) = o; }
    LDS_WAIT(); asm volatile("" ::: "memory");
}

struct Inputs { const float *x, *gains, *w1, *w3, *w2, *wqkv, *wo_a, *wdq, *qnorm, *wuq, *wo_b, *kvin, *wdkv, *kvnorm, *wukv; };

__device__ __forceinline__ void prologue_weights(Frame& F, const Inputs& I, unsigned char* ws) {
    LAS float* scr = (LAS float*)(F.lds + RING_OFF + F.wave * 16384);
    const int gw = F.vcu * NWAVES + F.wave, NGW = F.G * NWAVES;
    constexpr int I_UP = 176 * 16, I_DN = 32 * 44, I_QKV = 96 * 16, I_WO = 32 * 16, I_DQ = 16 * 16, I_UQ = 48 * 8, I_DKV = 16 * 16, I_UKV = 64 * 4;
    constexpr int T_UP = 8 * I_UP, T_DN = 8 * I_DN, T_QKV = 2 * I_QKV, T_WOA = 2 * I_WO, T_DQ = 2 * I_DQ, T_UQ = 2 * I_UQ, T_WOB = 2 * I_WO;
    constexpr int NITEMS = T_UP + T_DN + T_QKV + T_WOA + T_DQ + T_UQ + T_WOB + I_DKV + I_UKV;
    for (int it = gw; it < NITEMS; it += NGW) {
        int r = it;
        if (r < T_UP) { const int ls = r / I_UP, q = r % I_UP, g = q >> 4, k0 = (q & 15) * 64, n0 = g * 32, pn = n0 >> 8, c0 = n0 & 255, bj = c0 >> 7, cw0 = c0 & 127, l = ls >> 1, s = ls & 1;
            const float* src = (bj ? I.w3 : I.w1) + (size_t)ls * D * FF + pn * 128 + cw0;
            conv_item(src, FF, I.gains + (l * 6 + (s ? 4 : 0)) * D, (bf16*)(ws + ws_wffn(l, s)) + (size_t)n0 * D, D, k0, scr, F.lane); continue; } r -= T_UP;
        if (r < T_DN) { const int ls = r / I_DN, q = r % I_DN, g = q / 44, k0 = (q % 44) * 64, n0 = g * 32, l = ls >> 1, s = ls & 1;
            conv_item(I.w2 + (size_t)ls * FF * D + n0, D, nullptr, (bf16*)(ws + ws_wffn(l, s) + UP_W_BYTES) + (size_t)n0 * FF, FF, k0, scr, F.lane); continue; } r -= T_DN;
        if (r < T_QKV) { const int l = r / I_QKV, q = r % I_QKV, g = q >> 4, k0 = (q & 15) * 64, n0 = g * 32, pn = n0 >> 8, which = pn >> 2, hp = pn & 3, c0 = n0 & 255, bj = c0 >> 7, cw0 = c0 & 127;
            const int head = 2 * hp + (cw0 >> 6), d = (cw0 & 63) + 64 * bj, sc = which * 1024 + head * 128 + d;
            conv_item(I.wqkv + (size_t)l * D * 3072 + sc, 3072, I.gains + (l * 6 + 2) * D, (bf16*)(ws + ws_wmoba(l)) + (size_t)n0 * D, D, k0, scr, F.lane); continue; } r -= T_QKV;
        if (r < T_WOA) { const int l = r / I_WO, q = r % I_WO, g = q >> 4, k0 = (q & 15) * 64, n0 = g * 32;
            conv_item(I.wo_a + (size_t)l * D * D + n0, D, nullptr, (bf16*)(ws + ws_wmoba(l) + 6 * MiB) + (size_t)n0 * D, D, k0, scr, F.lane); continue; } r -= T_WOA;
        if (r < T_DQ) { const int j = r / I_DQ, q = r % I_DQ, g = q >> 4, k0 = (q & 15) * 64, n0 = g * 32;
            conv_item(I.wdq + (size_t)j * D * QL + n0, QL, I.gains + ((2 + j) * 6 + 2) * D, (bf16*)(ws + ws_wmla(j)) + (size_t)n0 * D, D, k0, scr, F.lane); continue; } r -= T_DQ;
        if (r < T_UQ) { const int j = r / I_UQ, q = r % I_UQ, g = q >> 3, k0 = (q & 7) * 64, n0 = g * 32, pn = n0 >> 8, c0 = n0 & 255, bj = c0 >> 7, cw0 = c0 & 127;
            int sc; if (pn < 4) sc = (2 * pn + bj) * QKD + cw0; else sc = (4 * (pn - 4) + (cw0 >> 5)) * QKD + 128 + (cw0 & 31) + 32 * bj;
            conv_item(I.wuq + (size_t)j * QL * 1536 + sc, 1536, I.qnorm + j * QL, (bf16*)(ws + ws_wmla(j) + 1 * MiB) + (size_t)n0 * QL, QL, k0, scr, F.lane); continue; } r -= T_UQ;
        if (r < T_WOB) { const int j = r / I_WO, q = r % I_WO, g = q >> 4, k0 = (q & 15) * 64, n0 = g * 32;
            conv_item(I.wo_b + (size_t)j * D * D + n0, D, nullptr, (bf16*)(ws + ws_wmla(j) + 2 * MiB + 512 * 1024) + (size_t)n0 * D, D, k0, scr, F.lane); continue; } r -= T_WOB;
        if (r < I_DKV) { const int g = r >> 4, k0 = (r & 15) * 64, n0 = g * 32;
            conv_item(n0 < 320 ? I.wdkv + n0 : nullptr, 320, I.kvin, (bf16*)(ws + WS_WDKV) + (size_t)n0 * D, D, k0, scr, F.lane); continue; } r -= I_DKV;
        { const int g = r >> 2, k0 = (r & 3) * 64, n0 = g * 32;
            conv_item(I.wukv + n0, 2048, I.kvnorm, (bf16*)(ws + WS_WUKV) + (size_t)n0 * KVL, KVL, k0, scr, F.lane); }
    }
    const int gt = (F.vcu * NWAVES + F.wave) * 64 + F.lane, NGT = NGW * 64;
    for (int e = gt; e < SEQ * 96; e += NGT) {
        const int s = e / 96, i = e % 96; const bool A = i < 64; const int ii = A ? i : i - 64;
        const float expo = A ? (float)(2 * ii) / 128.0f : (float)(2 * ii) / 64.0f;
        const float inv = 1.0f / __builtin_exp2f(expo * 13.287712379549449f);
        const float ang = (float)s * inv;
        double rev = (double)ang * 0.15915494309189535; rev -= __builtin_floor(rev);
        const float rv = (float)rev, c = __builtin_amdgcn_cosf(rv), sn = __builtin_amdgcn_sinf(rv);
        if (A) { ((float*)(ws + WS_COSA))[s * 64 + ii] = c; ((float*)(ws + WS_SINA))[s * 64 + ii] = sn; }
        else { ((float*)(ws + WS_COSR))[s * 32 + ii] = c; ((float*)(ws + WS_SINR))[s * 32 + ii] = sn; }
    }
}

__device__ __forceinline__ void pass_norm(Frame& F, const float* xin, const bf16* Y, const float* gpost, float wgt, float* xout, bf16* XN) {
    const int gw = F.vcu * NWAVES + F.wave, NGW = F.G * NWAVES;
    for (int m = gw; m < M; m += NGW) {
        const GAS f32x4* xr = (const GAS f32x4*)(xin + (size_t)m * D) + F.lane;
        f32x4 v[4];
#pragma unroll
        for (int j = 0; j < 4; ++j) v[j] = xr[64 * j];
        if (Y) {
            const GAS unsigned long long* yr = (const GAS unsigned long long*)(Y + (size_t)m * D) + F.lane;
            f32x4 y[4]; float ss = 0.f;
#pragma unroll
            for (int j = 0; j < 4; ++j) { const unsigned long long w = yr[64 * j];
                y[j].x = bf2f((unsigned short)(w & 0xffff)); y[j].y = bf2f((unsigned short)((w >> 16) & 0xffff)); y[j].z = bf2f((unsigned short)((w >> 32) & 0xffff)); y[j].w = bf2f((unsigned short)(w >> 48));
                ss += (y[j].x * y[j].x + y[j].y * y[j].y) + (y[j].z * y[j].z + y[j].w * y[j].w); }
            const float rs = wgt * __builtin_amdgcn_rsqf(wave_sum(ss) * (1.f / D) + EPS);
#pragma unroll
            for (int j = 0; j < 4; ++j) { const f32x4 g = *((const GAS f32x4*)gpost + F.lane + 64 * j); v[j] = v[j] + y[j] * g * rs; }
        }
        float s2 = 0.f;
#pragma unroll
        for (int j = 0; j < 4; ++j) s2 += (v[j].x * v[j].x + v[j].y * v[j].y) + (v[j].z * v[j].z + v[j].w * v[j].w);
        const float rstd = __builtin_amdgcn_rsqf(wave_sum(s2) * (1.f / D) + EPS);
        GAS f32x4* xo = (GAS f32x4*)(xout + (size_t)m * D) + F.lane;
        GAS unsigned long long* o8 = (GAS unsigned long long*)(XN + (size_t)m * D) + F.lane;
#pragma unroll
        for (int j = 0; j < 4; ++j) { xo[64 * j] = v[j];
            o8[64 * j] = (unsigned long long)pk2(v[j].x * rstd, v[j].y * rstd) | ((unsigned long long)pk2(v[j].z * rstd, v[j].w * rstd) << 32); }
    }
}
__device__ __forceinline__ void pass_cqnorm(Frame& F, bf16* CQ) {
    const int gw = F.vcu * NWAVES + F.wave, NGW = F.G * NWAVES;
    for (int m = gw; m < M; m += NGW) {
        GAS v4u* p = (GAS v4u*)(CQ + (size_t)m * QL) + F.lane; const v4u w = *p; float f[8];
        f[0] = bf2f(w.x & 0xffff); f[1] = bf2f(w.x >> 16); f[2] = bf2f(w.y & 0xffff); f[3] = bf2f(w.y >> 16); f[4] = bf2f(w.z & 0xffff); f[5] = bf2f(w.z >> 16); f[6] = bf2f(w.w & 0xffff); f[7] = bf2f(w.w >> 16);
        float ss = 0.f;
#pragma unroll
        for (int j = 0; j < 8; ++j) ss += f[j] * f[j];
        const float rstd = __builtin_amdgcn_rsqf(wave_sum(ss) * (1.f / QL) + EPS);
        v4u o; o.x = pk2(f[0] * rstd, f[1] * rstd); o.y = pk2(f[2] * rstd, f[3] * rstd); o.z = pk2(f[4] * rstd, f[5] * rstd); o.w = pk2(f[6] * rstd, f[7] * rstd);
        *p = o;
    }
}
__device__ __forceinline__ void pass_ckr(Frame& F, const bf16* CKR, bf16* CKV, bf16* KR, const float* cosR, const float* sinR) {
    const int gw = F.vcu * NWAVES + F.wave, NGW = F.G * NWAVES;
    for (int m = gw; m < M; m += NGW) {
        const int s = m & 2047;
        float f[4]; { const unsigned long long w = *((const GAS unsigned long long*)(CKR + (size_t)m * 512) + F.lane);
            f[0] = bf2f((unsigned short)(w & 0xffff)); f[1] = bf2f((unsigned short)((w >> 16) & 0xffff)); f[2] = bf2f((unsigned short)((w >> 32) & 0xffff)); f[3] = bf2f((unsigned short)(w >> 48)); }
        const float ss = (f[0] * f[0] + f[1] * f[1]) + (f[2] * f[2] + f[3] * f[3]);
        const float rstd = __builtin_amdgcn_rsqf(wave_sum(ss) * (1.f / KVL) + EPS);
        *((GAS unsigned long long*)(CKV + (size_t)m * KVL) + F.lane) = (unsigned long long)pk2(f[0] * rstd, f[1] * rstd) | ((unsigned long long)pk2(f[2] * rstd, f[3] * rstd) << 32);
        if (F.lane < 32) { const float x1 = bf2f(CKR[(size_t)m * 512 + 256 + F.lane]), x2 = bf2f(CKR[(size_t)m * 512 + 288 + F.lane]); const float c = cosR[s * 32 + F.lane], sn = sinR[s * 32 + F.lane];
            KR[(size_t)m * 64 + F.lane] = (bf16)f2bf(x1 * c - x2 * sn); KR[(size_t)m * 64 + 32 + F.lane] = (bf16)f2bf(x1 * sn + x2 * c); }
    }
}
__device__ __forceinline__ void pass_kmean(Frame& F, const bf16* K, bf16* KM) {
    const int gw = F.vcu * NWAVES + F.wave, NGW = F.G * NWAVES;
    for (int it = gw; it < 64 * 8 * 4; it += NGW) {
        const int bhb = it >> 2, dg = it & 3, rg = F.lane >> 2, dc = (F.lane & 3) * 8;
        const bf16* base = K + ((size_t)bhb * 256) * 128 + dg * 32 + dc;
        float a[8] = {0.f, 0.f, 0.f, 0.f, 0.f, 0.f, 0.f, 0.f};
#pragma unroll 4
        for (int i = 0; i < 16; ++i) { const v4u w = *(const GAS v4u*)(base + (size_t)(rg + 16 * i) * 128);
            a[0] += bf2f(w.x & 0xffff); a[1] += bf2f(w.x >> 16); a[2] += bf2f(w.y & 0xffff); a[3] += bf2f(w.y >> 16); a[4] += bf2f(w.z & 0xffff); a[5] += bf2f(w.z >> 16); a[6] += bf2f(w.w & 0xffff); a[7] += bf2f(w.w >> 16); }
#pragma unroll
        for (int j = 0; j < 8; ++j) { float v = a[j]; v += __shfl_xor(v, 4); v += __shfl_xor(v, 8); v += __shfl_xor(v, 16); v += __shfl_xor(v, 32); a[j] = v * (1.f / 256.f); }
        if (F.lane < 4) { unsigned hi[8], lo[8];
#pragma unroll
            for (int j = 0; j < 8; ++j) { hi[j] = f2bf(a[j]); lo[j] = f2bf(a[j] - bf2f((unsigned short)hi[j])); }
            bf16* d = KM + ((size_t)bhb * 2) * 128 + dg * 32 + dc;
            v4u o; o.x = hi[0] | (hi[1] << 16); o.y = hi[2] | (hi[3] << 16); o.z = hi[4] | (hi[5] << 16); o.w = hi[6] | (hi[7] << 16); *(GAS v4u*)d = o;
            o.x = lo[0] | (lo[1] << 16); o.y = lo[2] | (lo[3] << 16); o.z = lo[4] | (lo[5] << 16); o.w = lo[6] | (lo[7] << 16); *(GAS v4u*)(d + 128) = o; }
    }
}

namespace att {
typedef short s16x4 __attribute__((ext_vector_type(4)));
typedef float f32x16 __attribute__((ext_vector_type(16)));
typedef LAS char* lptr;
constexpr int SHM_V = 16384, SHM_K = 16384, SHM_KR = 8192;
constexpr int L_V = 0, L_K = SHM_V, L_KR = L_K + SHM_K, L_WS = L_KR + SHM_KR;
constexpr float THR = 8.f;
#define KSWZ(row, colB) ((row) * 256 + ((colB) ^ (((row) & 7) << 4)))
#define KRSWZ(row, colB) ((row) * 128 + ((colB) ^ (((row) & 7) << 4)))
#define SBAR() __builtin_amdgcn_sched_barrier(0)
__device__ __forceinline__ int v_st(int k, int c) { const int kk = (k & ~0xC) | ((k & 4) << 1) | ((k & 8) >> 1); return ((kk >> 3) * 4 + (c >> 5)) * 512 + ((kk & 7) * 32 + (c & 31)) * 2; }
__device__ __forceinline__ int v_rd_base(int lane) { return ((lane & 3) << 3) | (((lane >> 2) & 3) << 6) | (((lane >> 4) & 1) << 5) | (((lane >> 5) & 1) << 8); }
constexpr int v_rd_off(int d0, int ks, int half) { return d0 * 512 + ks * 4096 + half * 2048; }
__device__ __forceinline__ int crow(int r, int hi) { return (r & 3) + 8 * (r >> 2) + 4 * hi; }
__device__ __forceinline__ unsigned cvtpk(float lo, float hi) { unsigned r; asm volatile("v_cvt_pk_bf16_f32 %0, %1, %2" : "=v"(r) : "v"(lo), "v"(hi)); return r; }

__device__ __forceinline__ void mask_causal(f32x16& p0, f32x16& p1, int dq) {
    const float NEG = -__builtin_inff();
#pragma unroll
    for (int r = 0; r < 16; ++r) { const int c = (r & 3) + 8 * (r >> 2); if (dq - c < 0) p0[r] = NEG; if (dq - c - 32 < 0) p1[r] = NEG; }
}
__device__ __forceinline__ void partialSM(f32x16& p0, f32x16& p1, float& m_reg, float& mn, float& alpha, const float SCALE) {
    float pmax = p0[0];
#pragma unroll
    for (int r = 1; r < 16; ++r) pmax = fmaxf(pmax, p0[r]);
#pragma unroll
    for (int r = 0; r < 16; ++r) pmax = fmaxf(pmax, p1[r]);
    { auto rr = __builtin_amdgcn_permlane32_swap(__float_as_uint(pmax), __float_as_uint(pmax), false, false);
      pmax = fmaxf(__uint_as_float(rr[0]), __uint_as_float(rr[1])); }
    const float C2 = 1.4426950408889634f * SCALE;
    if (__builtin_expect(__all((pmax - m_reg) * SCALE <= THR), 1)) { mn = m_reg; alpha = 1.f; }
    else { mn = fmaxf(m_reg, pmax); alpha = __builtin_amdgcn_exp2f((m_reg - mn) * C2); m_reg = mn; }
    const float mnL = -mn * C2;
#pragma unroll
    for (int r = 0; r < 16; ++r) p0[r] = fmaf(p0[r], C2, mnL);
#pragma unroll
    for (int r = 0; r < 16; ++r) p1[r] = fmaf(p1[r], C2, mnL);
#pragma unroll
    for (int r = 0; r < 16; ++r) p0[r] = __builtin_amdgcn_exp2f(p0[r]);
}
__device__ __forceinline__ void finishSM(f32x16& p0, f32x16& p1, float alpha, float& l_reg, bf16x8& pa0, bf16x8& pa1, bf16x8& pa2, bf16x8& pa3) {
#pragma unroll
    for (int r = 0; r < 16; ++r) p1[r] = __builtin_amdgcn_exp2f(p1[r]);
    float ps = 0;
#pragma unroll
    for (int r = 0; r < 16; ++r) ps += p0[r];
#pragma unroll
    for (int r = 0; r < 16; ++r) ps += p1[r];
    { auto rr = __builtin_amdgcn_permlane32_swap(__float_as_uint(ps), __float_as_uint(ps), false, false);
      ps = __uint_as_float(rr[0]) + __uint_as_float(rr[1]); }
    l_reg = l_reg * alpha + ps;
#define PK4(P, B_, OUT) do { unsigned a0 = cvtpk(P[B_+0], P[B_+1]), a1 = cvtpk(P[B_+2], P[B_+3]);                          \
        unsigned b0 = cvtpk(P[B_+4], P[B_+5]), b1 = cvtpk(P[B_+6], P[B_+7]);                                             \
        auto r0 = __builtin_amdgcn_permlane32_swap(a0, b0, false, false); auto r1 = __builtin_amdgcn_permlane32_swap(a1, b1, false, false); \
        v4u w = {r0[0], r1[0], r0[1], r1[1]}; OUT = __builtin_bit_cast(bf16x8, w); } while (0)
    PK4(p0, 0, pa0); PK4(p0, 8, pa1); PK4(p1, 0, pa2); PK4(p1, 8, pa3);
#undef PK4
}
template <int ND0>
__device__ __forceinline__ void qkt(f32x16& p0, f32x16& p1, lptr K_lds, lptr KR_lds, int r32, int hi, const bf16x8* qr) {
    p0 = f32x16{}; p1 = f32x16{};
    lptr kb[4];
#pragma unroll
    for (int dd = 0; dd < 4; ++dd) kb[dd] = K_lds + KSWZ(r32, (dd * 16 + hi * 8) * 2);
#pragma unroll
    for (int d0 = 0; d0 < 8; ++d0) { lptr a = kb[d0 & 3] + (d0 >> 2) * 128;
        const bf16x8 b0 = *(const LAS bf16x8*)a, b1 = *(const LAS bf16x8*)(a + 32 * 256);
        p0 = __builtin_amdgcn_mfma_f32_32x32x16_bf16(b0, qr[d0], p0, 0, 0, 0);
        p1 = __builtin_amdgcn_mfma_f32_32x32x16_bf16(b1, qr[d0], p1, 0, 0, 0); }
    if constexpr (ND0 > 8) {
#pragma unroll
        for (int d0 = 8; d0 < ND0; ++d0) { lptr a = KR_lds + KRSWZ(r32, ((d0 - 8) * 2 + hi) * 16);
            const bf16x8 b0 = *(const LAS bf16x8*)a, b1 = *(const LAS bf16x8*)(a + 32 * 128);
            p0 = __builtin_amdgcn_mfma_f32_32x32x16_bf16(b0, qr[d0], p0, 0, 0, 0);
            p1 = __builtin_amdgcn_mfma_f32_32x32x16_bf16(b1, qr[d0], p1, 0, 0, 0); }
    }
}
__device__ __forceinline__ void pv_tile(f32x16* o, unsigned vb0, bf16x8 pa0, bf16x8 pa1, bf16x8 pa2, bf16x8 pa3) {
#define TRRD(dst, off) asm volatile("ds_read_b64_tr_b16 %0, %1 offset:%2" : "=&v"(dst) : "v"(vb0), "i"(off) : "memory")
#define PV_D0(d0) do { s16x4 l0, l1, l2, l3, h0, h1, h2, h3; constexpr int b_ = v_rd_off(d0, 0, 0); \
        TRRD(l0, b_); TRRD(h0, b_ + 2048); TRRD(l1, b_ + 4096); TRRD(h1, b_ + 6144); TRRD(l2, b_ + 8192); TRRD(h2, b_ + 10240); TRRD(l3, b_ + 12288); TRRD(h3, b_ + 14336); \
        asm volatile("s_waitcnt lgkmcnt(0)" ::: "memory"); SBAR();   \
        o[d0] = __builtin_amdgcn_mfma_f32_32x32x16_bf16(pa0, (bf16x8){l0[0], l0[1], l0[2], l0[3], h0[0], h0[1], h0[2], h0[3]}, o[d0], 0, 0, 0);   \
        o[d0] = __builtin_amdgcn_mfma_f32_32x32x16_bf16(pa1, (bf16x8){l1[0], l1[1], l1[2], l1[3], h1[0], h1[1], h1[2], h1[3]}, o[d0], 0, 0, 0);   \
        o[d0] = __builtin_amdgcn_mfma_f32_32x32x16_bf16(pa2, (bf16x8){l2[0], l2[1], l2[2], l2[3], h2[0], h2[1], h2[2], h2[3]}, o[d0], 0, 0, 0);   \
        o[d0] = __builtin_amdgcn_mfma_f32_32x32x16_bf16(pa3, (bf16x8){l3[0], l3[1], l3[2], l3[3], h3[0], h3[1], h3[2], h3[3]}, o[d0], 0, 0, 0); } while (0)
    PV_D0(0); PV_D0(1); PV_D0(2); PV_D0(3);
#undef PV_D0
#undef TRRD
}

template <bool MLA>
__device__ __forceinline__ void attn_block(const bf16* Qb, const bf16* Kn, const bf16* Kr, const bf16* Vv, bf16* Ob, const bf16* kmean, int qb, lptr lds) {
    constexpr int ND0 = MLA ? 12 : 8, QS = MLA ? 192 : 128;
    constexpr float SCALE = MLA ? 0.07216878364870322f : 0.08838834764831845f;
    int tid = threadIdx.x; asm volatile("" : "+v"(tid));
    const int wid = __builtin_amdgcn_readfirstlane(tid >> 6), lane = tid & 63, r32 = lane & 31, hi = lane >> 5;
    const int P0 = qb * 256, qlo = P0 + wid * 32, qm = qlo + r32 - 4 * hi;
    lptr V_lds = lds + L_V; lptr K_lds = lds + L_K; lptr KR_lds = lds + L_KR;
    LAS float* wsf = (LAS float*)(lds + L_WS) + wid * 64; LAS float* li_l = wsf; LAS float* al_l = wsf + 32;
    const int sr = tid >> 4, sc = (tid & 15) * 8, vst0 = v_st(sr, sc), vst1 = v_st(32 + sr, sc), kws = KSWZ(sr, sc * 2);
    const int krr = tid >> 3, krc = tid & 7, krws = KRSWZ(krr, krc * 16);
    const unsigned vb0 = (unsigned)(uintptr_t)V_lds + v_rd_base(lane);
    bf16x8 qr[ND0];
#pragma unroll
    for (int d0 = 0; d0 < ND0; ++d0) qr[d0] = *(const GAS bf16x8*)(Qb + (size_t)(wid * 32 + r32) * QS + d0 * 16 + hi * 8);
    unsigned sel = 0xffu;
    if constexpr (!MLA) {
        if (qb <= 3) sel = (1u << qb) - 1u;
        else {
            __syncthreads();
            if (tid < 256) { const int blk = tid >> 5, hl = (tid >> 4) & 1, ch = tid & 15;
                const bf16x8 w = *(const GAS bf16x8*)(kmean + ((blk * 2 + hl) * 128 + ch * 8));
                *(LAS bf16x8*)(K_lds + KSWZ(blk + 32 * hl, ch * 16)) = w; }
            __syncthreads();
            f32x16 g0, g1; qkt<8>(g0, g1, K_lds, KR_lds, r32, hi, qr);
            float gl[4], go[4], g[8];
#pragma unroll
            for (int j = 0; j < 4; ++j) { gl[j] = g0[j] + g1[j]; go[j] = __shfl_xor(gl[j], 32); }
#pragma unroll
            for (int j = 0; j < 4; ++j) { g[j] = hi ? go[j] : gl[j]; g[4 + j] = hi ? gl[j] : go[j]; }
            sel = 0u;
#pragma unroll
            for (int j = 0; j < 8; ++j) { int rank = 0;
#pragma unroll
                for (int i = 0; i < 8; ++i) if (i != j) rank += (i < qb && (g[i] > g[j] || (g[i] == g[j] && i < j))) ? 1 : 0;
                if (j < qb && rank < 3) sel |= 1u << j; }
        }
    }
    float m_reg = -1e30f, l_reg = 0.f; f32x16 o[4] = {};
    const int NT = 4 * (qb + 1);
    bf16x8 st_k0, st_k1, st_v0, st_v1, st_kr;
#define SLOAD(kb) do { st_k0 = *(const GAS bf16x8*)(Kn + (size_t)((kb) + sr) * 128 + sc); st_k1 = *(const GAS bf16x8*)(Kn + (size_t)((kb) + 32 + sr) * 128 + sc); \
                       st_v0 = *(const GAS bf16x8*)(Vv + (size_t)((kb) + sr) * 128 + sc); st_v1 = *(const GAS bf16x8*)(Vv + (size_t)((kb) + 32 + sr) * 128 + sc); \
                       if constexpr (MLA) st_kr = *(const GAS bf16x8*)(Kr + (size_t)((kb) + krr) * 64 + krc * 8); } while (0)
    SLOAD(0);
    for (int t = 0; t < NT; ++t) {
        const int kb = t * 64, j = t >> 2;
        __syncthreads();
        *(LAS bf16x8*)(K_lds + kws) = st_k0; *(LAS bf16x8*)(K_lds + kws + 32 * 256) = st_k1;
        *(LAS bf16x8*)(V_lds + vst0) = st_v0; *(LAS bf16x8*)(V_lds + vst1) = st_v1;
        if constexpr (MLA) *(LAS bf16x8*)(KR_lds + krws) = st_kr;
        if (t + 1 < NT) SLOAD(kb + 64);
        __syncthreads();
        bool act = kb <= qlo + 31;
        if constexpr (!MLA) { if (j < qb) act = __any((sel >> j) & 1u) != 0; }
        if (act) {
            f32x16 p0, p1; float mn, alpha; bf16x8 pa0, pa1, pa2, pa3;
            qkt<ND0>(p0, p1, K_lds, KR_lds, r32, hi, qr);
            if (j == qb) { if (kb + 63 > qlo) mask_causal(p0, p1, qm - kb); }
            else if constexpr (!MLA) { if (!((sel >> j) & 1u)) { const float NEG = -__builtin_inff();
#pragma unroll
                for (int r = 0; r < 16; ++r) { p0[r] = NEG; p1[r] = NEG; } } }
            partialSM(p0, p1, m_reg, mn, alpha, SCALE);
            if (__any(alpha < 1.f)) { if (hi == 0) al_l[r32] = alpha; asm volatile("s_waitcnt lgkmcnt(0)" ::: "memory");
#pragma unroll
                for (int d_ = 0; d_ < 4; ++d_)
#pragma unroll
                    for (int r = 0; r < 16; ++r) o[d_][r] *= al_l[crow(r, hi)]; }
            finishSM(p0, p1, alpha, l_reg, pa0, pa1, pa2, pa3); SBAR();
            pv_tile(o, vb0, pa0, pa1, pa2, pa3);
        }
    }
#undef SLOAD
    if (hi == 0) li_l[r32] = l_reg; asm volatile("s_waitcnt lgkmcnt(0)" ::: "memory");
    bf16* Ow = Ob + (size_t)(wid * 32) * D;
#pragma unroll
    for (int r = 0; r < 16; ++r) { const int orow = crow(r, hi); const float rl = __builtin_amdgcn_rcpf(li_l[orow]);
#pragma unroll
        for (int d0 = 0; d0 < 4; ++d0) { const float v = o[d0][r] * rl; const float vn = __shfl_xor(v, 1);
            if ((r32 & 1) == 0) *(GAS unsigned*)(Ow + (size_t)orow * D + d0 * 32 + r32) = cvtpk(v, vn); } }
}
#undef KSWZ
#undef KRSWZ
#undef SBAR
}

template <bool MLA>
__device__ __forceinline__ void attn_phase(Frame& F, const bf16* Q, const bf16* Kn, const bf16* Kr, const bf16* Vv, bf16* O, const bf16* KM) {
    constexpr int QS = MLA ? 192 : 128;
    for (int u = F.vcu; u < 256; u += F.G) {
        const int bh = u >> 2, pr = u & 3, b = bh >> 3, h = bh & 7;
#pragma unroll 1
        for (int pass = 0; pass < 2; ++pass) { const int qb = pass ? pr : 7 - pr;
            att::attn_block<MLA>(Q + ((size_t)bh * SEQ + qb * 256) * QS, Kn + (size_t)bh * SEQ * 128, Kr + (size_t)b * SEQ * 64, Vv + (size_t)bh * SEQ * 128,
                                 O + ((size_t)b * SEQ + qb * 256) * D + h * 128, KM + (size_t)bh * 8 * 2 * 128, qb, (att::lptr)(F.lds + RING_OFF)); }
    }
}

struct Args { const float* in[15]; float* out; unsigned char* ws; };
__global__ void __launch_bounds__(NWAVES * 64, 2) mk_fwd(Args args) {
    extern __shared__ __attribute__((aligned(16))) unsigned char lds[];
    LAS unsigned char* const L = (LAS unsigned char*)lds;
    for (int u = threadIdx.x; u < (LDS_BYTES - LDSCTL_OFF) / 4; u += NWAVES * 64) ((LAS unsigned*)(L + LDSCTL_OFF))[u] = 0u;
    __syncthreads();
    (void)xcd_barrier_post((unsigned*)((gu32*)(args.ws + WS_CTL) + CW_BAR), (volatile LAS unsigned*)(L + MISC_OFF) + 8);
#define GRID_BAR() do { unsigned char* wsb_ = args.ws; asm volatile("" : "+s"(wsb_)); unsigned stb_ = MISC_OFF + 32; asm volatile("" : "+s"(stb_)); XcdBarrier b_; \
        b_.bar = (unsigned*)(wsb_ + WS_CTL) + CW_BAR; b_.x = xb_xcc_id(); b_.st = (volatile LAS unsigned*)(L + stb_); xcd_barrier(b_); } while (0)
#define PHASE_BEGIN() unsigned char* ws = args.ws; asm volatile("" : "+s"(ws)); Frame F = mk_frame(L, ws); float* X = args.out; \
    bf16* XN = (bf16*)(ws + WS_XN); bf16* Y = (bf16*)(ws + WS_Y); bf16* BIG = (bf16*)(ws + WS_BIG); (void)X; (void)XN; (void)Y; (void)BIG; (void)F

    { PHASE_BEGIN();
      Inputs I; I.x = args.in[0]; I.gains = args.in[1]; I.w1 = args.in[2]; I.w3 = args.in[3]; I.w2 = args.in[4]; I.wqkv = args.in[5]; I.wo_a = args.in[6]; I.wdq = args.in[7]; I.qnorm = args.in[8];
      I.wuq = args.in[9]; I.wo_b = args.in[10]; I.kvin = args.in[11]; I.wdkv = args.in[12]; I.kvnorm = args.in[13]; I.wukv = args.in[14];
      prologue_weights(F, I, ws);
      pass_norm(F, I.x, nullptr, nullptr, 0.f, X, XN); }
    GRID_BAR();

#pragma unroll 1
    for (int hl = 0; hl < 2 * NLAYER; ++hl) {
        const int l = hl >> 1, s = hl & 1;
        { PHASE_BEGIN(); pg8::Gemm g{XN, (const bf16*)(ws + ws_wffn(l, s)), M, 2 * FF, D}; pg8::StaticOrder S; S.init(M, 2 * FF, F.G, F.bx);
          pg8::EpiSwiGLU E{BIG, FF};
          pg8::gemm_phase<pg8::EpiSwiGLU, pg8::StaticOrder, true, true>(F.lds + RING_OFF, g, S, E); }
        GRID_BAR();
        { PHASE_BEGIN(); pg8::Gemm g{BIG, (const bf16*)(ws + ws_wffn(l, s) + UP_W_BYTES), M, D, FF}; pg8::StaticOrder S; S.init(M, D, F.G, F.bx);
          pg8::EpiPlain E{Y, D};
          pg8::gemm_phase<pg8::EpiPlain, pg8::StaticOrder, true, true>(F.lds + RING_OFF, g, S, E); }
        GRID_BAR();
        { PHASE_BEGIN(); pass_norm(F, X, Y, args.in[1] + (l * 6 + (s ? 5 : 1)) * D, 0.5f, X, XN); }
        GRID_BAR();
        if (s == 0) {
            if (l < 2) {
                { PHASE_BEGIN(); bf16* Qh = BIG; bf16* Kh = BIG + (size_t)M * D; bf16* Vh = BIG + (size_t)2 * M * D;
                  pg8::Gemm g{XN, (const bf16*)(ws + ws_wmoba(l)), M, 3 * D, D}; pg8::StaticOrder S; S.init(M, 3 * D, F.G, F.bx);
                  pg8::EpiQKV E{Qh, (size_t)M * D, (const float*)(ws + WS_COSA), (const float*)(ws + WS_SINA)}; (void)Kh; (void)Vh;
                  pg8::gemm_phase<pg8::EpiQKV, pg8::StaticOrder, true, true>(F.lds + RING_OFF, g, S, E); }
                GRID_BAR();
                { PHASE_BEGIN(); pass_kmean(F, BIG + (size_t)M * D, (bf16*)(ws + WS_KMEAN)); }
                GRID_BAR();
                { PHASE_BEGIN(); attn_phase<false>(F, BIG, BIG + (size_t)M * D, BIG + (size_t)M * D, BIG + (size_t)2 * M * D, XN, (const bf16*)(ws + WS_KMEAN)); }
                GRID_BAR();
            } else {
                const int j = l - 2;
                { PHASE_BEGIN(); bf16* CQ = BIG + (size_t)M * 8 * QKD;
                  pg8::Gemm g{XN, (const bf16*)(ws + ws_wmla(j)), M, QL, D}; pg8::StaticOrder S; S.init(M, QL, F.G, F.bx);
                  pg8::EpiPlain E{CQ, QL};
                  pg8::gemm_phase<pg8::EpiPlain, pg8::StaticOrder, true, true>(F.lds + RING_OFF, g, S, E); }
                GRID_BAR();
                { PHASE_BEGIN(); pass_cqnorm(F, BIG + (size_t)M * 8 * QKD); }
                GRID_BAR();
                { PHASE_BEGIN(); bf16* CQ = BIG + (size_t)M * 8 * QKD;
                  pg8::Gemm g{CQ, (const bf16*)(ws + ws_wmla(j) + 1 * MiB), M, 1536, QL}; pg8::StaticOrder S; S.init(M, 1536, F.G, F.bx);
                  pg8::EpiUQ E{BIG, (const float*)(ws + WS_COSR), (const float*)(ws + WS_SINR)};
                  pg8::gemm_phase<pg8::EpiUQ, pg8::StaticOrder, true, true>(F.lds + RING_OFF, g, S, E); }
                GRID_BAR();
                { PHASE_BEGIN(); attn_phase<true>(F, BIG, (const bf16*)(ws + WS_KN), (const bf16*)(ws + WS_KR), (const bf16*)(ws + WS_VS), XN, (const bf16*)(ws + WS_KMEAN)); }
                GRID_BAR();
            }
            { PHASE_BEGIN(); const bf16* Wo = (l < 2) ? (const bf16*)(ws + ws_wmoba(l) + 6 * MiB) : (const bf16*)(ws + ws_wmla(l - 2) + 2 * MiB + 512 * 1024);
              pg8::Gemm g{XN, Wo, M, D, D}; pg8::StaticOrder S; S.init(M, D, F.G, F.bx);
              pg8::EpiPlain E{Y, D};
              pg8::gemm_phase<pg8::EpiPlain, pg8::StaticOrder, true, true>(F.lds + RING_OFF, g, S, E); }
            GRID_BAR();
            { PHASE_BEGIN(); pass_norm(F, X, Y, args.in[1] + (l * 6 + 3) * D, 1.0f, X, XN); }
            GRID_BAR();
        }
        if (hl == 3) {
            { PHASE_BEGIN(); pg8::Gemm g{XN, (const bf16*)(ws + WS_WDKV), M, 512, D}; pg8::StaticOrder S; S.init(M, 512, F.G, F.bx);
              pg8::EpiPlain E{BIG, 512};
              pg8::gemm_phase<pg8::EpiPlain, pg8::StaticOrder, true, true>(F.lds + RING_OFF, g, S, E); }
            GRID_BAR();
            { PHASE_BEGIN(); pass_ckr(F, BIG, BIG + (size_t)M * 512, (bf16*)(ws + WS_KR), (const float*)(ws + WS_COSR), (const float*)(ws + WS_SINR)); }
            GRID_BAR();
            { PHASE_BEGIN(); pg8::Gemm g{BIG + (size_t)M * 512, (const bf16*)(ws + WS_WUKV), M, 2048, KVL}; pg8::StaticOrder S; S.init(M, 2048, F.G, F.bx);
              pg8::EpiUKV E{(bf16*)(ws + WS_KN), (bf16*)(ws + WS_VS)};
              pg8::gemm_phase<pg8::EpiUKV, pg8::StaticOrder, true, true>(F.lds + RING_OFF, g, S, E); }
            GRID_BAR();
        }
    }
#undef GRID_BAR
#undef PHASE_BEGIN
}

extern "C" void kernel_launch(void* const* d_in, const int* in_sizes, int n_in, void* d_out, int out_size, void* d_ws, size_t ws_size, hipStream_t stream) {
    static int grid = 0;
    if (grid == 0) {
        if (n_in != 15 || in_sizes[0] != M * D || out_size != M * D || ws_size < WS_END) { fprintf(stderr, "kernel_launch: unexpected shapes (n_in %d, in0 %d, out %d, ws %zu); nothing launched\n", n_in, n_in > 0 ? in_sizes[0] : -1, out_size, ws_size); grid = -1; return; }
        int dev = 0, cus = 0, per_cu = 0;
        if (hipGetDevice(&dev) != hipSuccess || hipDeviceGetAttribute(&cus, hipDeviceAttributeMultiprocessorCount, dev) != hipSuccess) { grid = -1; return; }
        if (hipFuncSetAttribute((const void*)mk_fwd, hipFuncAttributeMaxDynamicSharedMemorySize, LDS_BYTES) != hipSuccess) { fprintf(stderr, "kernel_launch: hipFuncSetAttribute failed\n"); grid = -1; return; }
        if (hipOccupancyMaxActiveBlocksPerMultiprocessor(&per_cu, (const void*)mk_fwd, NWAVES * 64, LDS_BYTES) != hipSuccess || per_cu < 1) { fprintf(stderr, "kernel_launch: occupancy query reports %d workgroups per CU\n", per_cu); }
        (void)hipGetLastError();
        grid = cus;
    }
    if (grid < 0) return;
    if (hipMemsetAsync((char*)d_ws + WS_CTL, 0, CTL_ZERO_BYTES, stream) != hipSuccess) return;
    Args a{};
    for (int i = 0; i < 15; ++i) a.in[i] = (const float*)d_in[i];
    a.out = (float*)d_out; a.ws = (unsigned char*)d_ws;
    hipLaunchKernelGGL(mk_fwd, dim3(grid), dim3(NWAVES * 64), LDS_BYTES, stream, a);
}
```

```cpp
#include <hip/hip_runtime.h>
#include <cstdio>
#include <cstdint>
namespace pg8 {
#define PG8_LAS __attribute__((address_space(3)))
typedef unsigned short bf16_t;
typedef short bf16x8 __attribute__((ext_vector_type(8)));
typedef float f32x4 __attribute__((ext_vector_type(4)));
typedef unsigned u32x4 __attribute__((ext_vector_type(4)));
constexpr int BM = 256, BK = 64, HALF = 128, HTB = HALF * BK * 2  , STAGE_BYTES = 8 * HTB, NXCD = 8, WGM = 8;

__host__ __device__ __forceinline__ int lds_byte(int r, int c) { const int st = (r >> 4) * 2 + (c >> 5), rr = r & 15, cc = c & 31, ob = rr * 64 + cc * 2; return st * 1024 + (ob ^ (((ob >> 9) & 1) << 5)); }
__host__ __device__ __forceinline__ void stage_rc(int b, int& R, int& C) { const int st = b / 1024, sb = b % 1024, swz = sb ^ (((sb >> 9) & 1) << 5); R = (st >> 1) * 16 + swz / 64; C = (st & 1) * 32 + (swz % 64) / 2; }
__host__ __device__ __forceinline__ int perm32(int rho) { const int n = rho >> 4, i = rho & 15; return 8 * (i >> 2) + 4 * n + (i & 3); }

struct Unit { int pm, pn; };
struct Gemm { const bf16_t* A; const bf16_t* Bt; int M, N, K; };

struct StaticOrder {
    int nM, nN, nwg, G, c;
    __host__ __device__ void init(int M, int N, int G_, int c_) { nM = M / BM; nN = N / BM; nwg = nM * nN; G = G_; c = c_; }
    __host__ __device__ bool next(int i, Unit& u) const {
        const long L = (long)i * G + c; if (L >= nwg) return false;
        int wgid = (int)L; { const int q = nwg / NXCD, r = nwg % NXCD, xcd = wgid % NXCD, off = wgid / NXCD; wgid = (xcd < r ? xcd * (q + 1) : r * (q + 1) + (xcd - r) * q) + off; }
        const int nig = WGM * nN, gid = wgid / nig, fm = gid * WGM, gsz = (nM - fm) < WGM ? (nM - fm) : WGM;
        u.pm = fm + ((wgid % nig) % gsz); u.pn = (wgid % nig) / gsz; return true;
    }
    __device__ __forceinline__ void a_ready(const Unit&) const {}
    __device__ __forceinline__ void done(const Unit&) const {}
};

__device__ __forceinline__ unsigned cvt_pk_bf16(float lo, float hi) { unsigned r; asm volatile("v_cvt_pk_bf16_f32 %0, %1, %2" : "=v"(r) : "v"(lo), "v"(hi)); return r; }
typedef float f32x2 __attribute__((ext_vector_type(2)));
__device__ __forceinline__ u32x4 pack8bf(const f32x4 v0, const f32x4 v1) { u32x4 w; w.x = cvt_pk_bf16(v0[0], v0[1]); w.y = cvt_pk_bf16(v0[2], v0[3]); w.z = cvt_pk_bf16(v1[0], v1[1]); w.w = cvt_pk_bf16(v1[2], v1[3]); return w; }
struct EpiPlain {
    static constexpr bool PERM = true, AFTER_DRAIN = false;
    bf16_t* O; int ldc; const float* rs;
    __device__ __forceinline__ void operator()(const f32x4 (&acc)[2][2][4][2], const Unit& u, int wr, int wc, int fr, int fq) const {
        const int row0 = u.pm * BM + wr * 64 + fr, col0 = u.pn * BM + wc * 32 + 8 * fq;
#pragma unroll
        for (int ai = 0; ai < 2; ++ai)
#pragma unroll
            for (int m = 0; m < 4; ++m) { const int row = row0 + ai * HALF + m * 16; bf16_t* rowp = O + (size_t)row * ldc + col0; const float sc = rs ? rs[row] : 1.f;
#pragma unroll
                for (int bj = 0; bj < 2; ++bj) *(u32x4*)(rowp + bj * HALF) = pack8bf(acc[ai][bj][m][0] * sc, acc[ai][bj][m][1] * sc); }
    }
};
struct EpiSwiGLU {
    static constexpr bool PERM = true, AFTER_DRAIN = false;
    bf16_t* O; int ldc; const float* rs;
    __device__ __forceinline__ void operator()(const f32x4 (&acc)[2][2][4][2], const Unit& u, int wr, int wc, int fr, int fq) const {
        const int row0 = u.pm * BM + wr * 64 + fr, col0 = u.pn * HALF + wc * 32 + 8 * fq;
#pragma unroll
        for (int ai = 0; ai < 2; ++ai)
#pragma unroll
            for (int m = 0; m < 4; ++m) { const int row = row0 + ai * HALF + m * 16; bf16_t* rowp = O + (size_t)row * ldc + col0; f32x4 h[2]; const float sc = rs[row];
#pragma unroll
                for (int n = 0; n < 2; ++n)
#pragma unroll
                    for (int j = 0; j < 4; ++j) { const float a = acc[ai][0][m][n][j] * sc, b = acc[ai][1][m][n][j] * sc;
                        h[n][j] = a * b * __builtin_amdgcn_rcpf(1.0f + __builtin_amdgcn_exp2f(-1.4426950408889634f * a)); }
                *(u32x4*)rowp = pack8bf(h[0], h[1]); }
    }
};
struct EpiQKV {
    static constexpr bool PERM = true, AFTER_DRAIN = false;
    bf16_t* Q; size_t kv_stride; const float* cs; const float* sn; const float* rs;
    __device__ __forceinline__ void operator()(const f32x4 (&acc)[2][2][4][2], const Unit& u, int wr, int wc, int fr, int fq) const {
        const int which = u.pn >> 2, hp = u.pn & 3, head = 2 * hp + (wc >> 1), d0 = 32 * (wc & 1) + 8 * fq;
        bf16_t* base = Q + (size_t)which * kv_stride;
#pragma unroll
        for (int ai = 0; ai < 2; ++ai)
#pragma unroll
            for (int m = 0; m < 4; ++m) { const int row = u.pm * BM + ai * HALF + wr * 64 + m * 16 + fr, b = row >> 11, s = row & 2047;
                bf16_t* dst = base + ((size_t)((b * 8 + head) * 2048 + s)) * 128 + d0;
                const float rsc = rs[row];
                f32x4 x1[2] = {acc[ai][0][m][0] * rsc, acc[ai][0][m][1] * rsc}, x2[2] = {acc[ai][1][m][0] * rsc, acc[ai][1][m][1] * rsc};
                if (which < 2) {
#pragma unroll
                    for (int n = 0; n < 2; ++n) { const f32x4 c = *(const f32x4*)(cs + s * 64 + d0 + 4 * n), sv = *(const f32x4*)(sn + s * 64 + d0 + 4 * n);
                        const f32x4 a = x1[n], bb = x2[n]; x1[n] = a * c - bb * sv; x2[n] = a * sv + bb * c; } }
                *(u32x4*)dst = pack8bf(x1[0], x1[1]); *(u32x4*)(dst + 64) = pack8bf(x2[0], x2[1]); }
    }
};
struct EpiUQ {
    static constexpr bool PERM = true, AFTER_DRAIN = false;
    bf16_t* Q; const float* cs; const float* sn;
    __device__ __forceinline__ void operator()(const f32x4 (&acc)[2][2][4][2], const Unit& u, int wr, int wc, int fr, int fq) const {
#pragma unroll
        for (int ai = 0; ai < 2; ++ai)
#pragma unroll
            for (int m = 0; m < 4; ++m) { const int row = u.pm * BM + ai * HALF + wr * 64 + m * 16 + fr, b = row >> 11, s = row & 2047;
                if (u.pn < 4) {
#pragma unroll
                    for (int bj = 0; bj < 2; ++bj) { bf16_t* dst = Q + ((size_t)((b * 8 + 2 * u.pn + bj) * 2048 + s)) * 192 + 32 * wc + 8 * fq;
                        *(u32x4*)dst = pack8bf(acc[ai][bj][m][0], acc[ai][bj][m][1]); }
                } else {
                    bf16_t* dst = Q + ((size_t)((b * 8 + 4 * (u.pn - 4) + wc) * 2048 + s)) * 192 + 128 + 8 * fq;
                    f32x4 x1[2] = {acc[ai][0][m][0], acc[ai][0][m][1]}, x2[2] = {acc[ai][1][m][0], acc[ai][1][m][1]};
#pragma unroll
                    for (int n = 0; n < 2; ++n) { const f32x4 c = *(const f32x4*)(cs + s * 32 + 8 * fq + 4 * n), sv = *(const f32x4*)(sn + s * 32 + 8 * fq + 4 * n);
                        const f32x4 a = x1[n], bb = x2[n]; x1[n] = a * c - bb * sv; x2[n] = a * sv + bb * c; }
                    *(u32x4*)dst = pack8bf(x1[0], x1[1]); *(u32x4*)(dst + 32) = pack8bf(x2[0], x2[1]); } }
    }
};
struct EpiUKV {
    static constexpr bool PERM = true, AFTER_DRAIN = false;
    bf16_t* KN; bf16_t* V;
    __device__ __forceinline__ void operator()(const f32x4 (&acc)[2][2][4][2], const Unit& u, int wr, int wc, int fr, int fq) const {
#pragma unroll
        for (int ai = 0; ai < 2; ++ai)
#pragma unroll
            for (int m = 0; m < 4; ++m) { const int row = u.pm * BM + ai * HALF + wr * 64 + m * 16 + fr, b = row >> 11, s = row & 2047;
                const size_t off = ((size_t)((b * 8 + u.pn) * 2048 + s)) * 128 + 32 * wc + 8 * fq;
                *(u32x4*)(KN + off) = pack8bf(acc[ai][0][m][0], acc[ai][0][m][1]); *(u32x4*)(V + off) = pack8bf(acc[ai][1][m][0], acc[ai][1][m][1]); }
    }
};

template <class Epi, class Sched, bool ALIGN_EPI = false, bool SP2 = false>
__device__ __forceinline__ void gemm_phase(PG8_LAS unsigned char* lds, const Gemm g, const Sched& S, const Epi& E) {
    int tid = threadIdx.x; asm volatile("" : "+v"(tid));
    const int wid = __builtin_amdgcn_readfirstlane(tid >> 6), lane = tid & 63, wr = wid >> 2, wc = wid & 3, fr = lane & 15, fq = lane >> 4;
    const int K = g.K, nt = K / BK;
    unsigned voffA[2], voffB[2];
#pragma unroll
    for (int i = 0; i < 2; ++i) { int R, C; stage_rc(tid * 16 + i * 8192, R, C); const int Rb = Epi::PERM ? ((R & ~31) + perm32(R & 31)) : R;
        voffA[i] = (unsigned)(R * K + C) * 2u; voffB[i] = (unsigned)(Rb * K + C) * 2u; }
    const size_t kstep = (size_t)(BK * 2);
    const size_t hstep = (size_t)HALF * K * 2;
    const size_t tstep = 2 * hstep;
    const unsigned ldsw = (unsigned)wid * 1024u;
    const int aoff = lds_byte(wr * 64 + fr, fq * 8), boff = lds_byte(wc * 32 + fr, fq * 8);
#define PG8_SA(b, h) (((b) * 2 + (h)) * HTB)
#define PG8_SB(b, h) ((4 + (b) * 2 + (h)) * HTB)
#define PG8_STAGE(bufoff, gbase, voff) do { _Pragma("unroll") for (int _i = 0; _i < 2; ++_i) \
        __builtin_amdgcn_global_load_lds((const unsigned*)((const char*)(gbase) + (voff)[_i]), (PG8_LAS unsigned*)(lds + (bufoff) + ldsw + _i * 8192), 16, 0, 0); } while (0)
#define PG8_LDA(dst, b, h) do { _Pragma("unroll") for (int m = 0; m < 4; ++m) _Pragma("unroll") for (int k = 0; k < 2; ++k) dst[m][k] = *(const PG8_LAS bf16x8*)(lds + PG8_SA(b, h) + aoff + m * 2048 + k * 1024); } while (0)
#define PG8_LDB(dst, b, h) do { _Pragma("unroll") for (int n = 0; n < 2; ++n) _Pragma("unroll") for (int k = 0; k < 2; ++k) dst[n][k] = *(const PG8_LAS bf16x8*)(lds + PG8_SB(b, h) + boff + n * 2048 + k * 1024); } while (0)
#define PG8_MMA(ai, bj, At, Bt) do { __builtin_amdgcn_s_setprio(1); _Pragma("unroll") for (int m = 0; m < 4; ++m) _Pragma("unroll") for (int n = 0; n < 2; ++n) _Pragma("unroll") for (int k = 0; k < 2; ++k) \
        acc[ai][bj][m][n] = __builtin_amdgcn_mfma_f32_16x16x32_bf16(Bt[n][k], At[m][k], acc[ai][bj][m][n], 0, 0, 0); __builtin_amdgcn_s_setprio(0); } while (0)
#define PG8_WAIT_V(n) asm volatile("s_waitcnt vmcnt(" #n ")" ::: "memory")
#define PG8_WAIT_L(n) asm volatile("s_waitcnt lgkmcnt(" #n ")" ::: "memory")
#define PG8_BAR __builtin_amdgcn_s_barrier()
#define PG8_SCHED __builtin_amdgcn_sched_barrier(0)
    Unit cur, nxt; int ui = 0;
    if (!S.next(0, cur)) return;
    f32x4 acc[2][2][4][2];
#pragma unroll
    for (int a = 0; a < 2; ++a)
#pragma unroll
        for (int b = 0; b < 2; ++b)
#pragma unroll
            for (int m = 0; m < 4; ++m)
#pragma unroll
                for (int n = 0; n < 2; ++n) acc[a][b][m][n] = (f32x4){0.f, 0.f, 0.f, 0.f};
    bf16x8 At[4][2], B0[2][2], B1[2][2];
    const char* cA = (const char*)g.A + (size_t)cur.pm * tstep; const char* cB = (const char*)g.Bt + (size_t)cur.pn * tstep;
    S.a_ready(cur);
    if constexpr (SP2) {
        PG8_STAGE(PG8_SB(0, 0), cB, voffB); PG8_STAGE(PG8_SB(0, 1), cB + hstep, voffB); PG8_STAGE(PG8_SA(0, 0), cA, voffA); PG8_STAGE(PG8_SA(0, 1), cA + hstep, voffA);
        if (wr == 1) PG8_BAR;
        PG8_WAIT_V(2); PG8_BAR;
        PG8_STAGE(PG8_SB(1, 0), cB + kstep, voffB); PG8_STAGE(PG8_SA(1, 0), cA + kstep, voffA); PG8_STAGE(PG8_SB(1, 1), cB + hstep + kstep, voffB);
        PG8_WAIT_V(6); PG8_BAR;
    } else {
        PG8_STAGE(PG8_SB(0, 0), cB, voffB); PG8_STAGE(PG8_SA(0, 0), cA, voffA); PG8_STAGE(PG8_SB(0, 1), cB + hstep, voffB); PG8_STAGE(PG8_SA(0, 1), cA + hstep, voffA);
        if (wr == 1) PG8_BAR;
        PG8_WAIT_V(4); PG8_BAR;
        PG8_STAGE(PG8_SB(1, 0), cB + kstep, voffB); PG8_STAGE(PG8_SA(1, 0), cA + kstep, voffA); PG8_STAGE(PG8_SB(1, 1), cB + hstep + kstep, voffB);
        PG8_WAIT_V(6); PG8_BAR;
    }
    for (;;) {
        const bool has_next = S.next(ui + 1, nxt);
        const char* nA = has_next ? (const char*)g.A + (size_t)nxt.pm * tstep : cA; const char* nB = has_next ? (const char*)g.Bt + (size_t)nxt.pn * tstep : cB;
        for (int t = 0; t < nt; t += 2) {
            const bool last = (t == nt - 2);
            const char* a1 = cA + (size_t)(t + 1) * kstep;
            const char* a2 = last ? nA : cA + (size_t)(t + 2) * kstep; const char* b2 = last ? nB : cB + (size_t)(t + 2) * kstep;
            const char* a3 = a2 + kstep; const char* b3 = b2 + kstep;
            if (last && has_next) S.a_ready(nxt);
            if constexpr (SP2) {
            PG8_LDB(B0, 0, 0); PG8_LDB(B1, 0, 1); PG8_SCHED; PG8_LDA(At, 0, 0); PG8_STAGE(PG8_SA(1, 1), a1 + hstep, voffA);
            PG8_WAIT_V(8); PG8_WAIT_L(0); PG8_BAR; PG8_MMA(0, 0, At, B0); PG8_MMA(0, 1, At, B1); PG8_BAR; PG8_SCHED;
            PG8_LDA(At, 0, 1); PG8_STAGE(PG8_SB(0, 0), b2, voffB); PG8_STAGE(PG8_SB(0, 1), b2 + hstep, voffB); PG8_STAGE(PG8_SA(0, 0), a2, voffA);
            PG8_WAIT_V(8); PG8_WAIT_L(0); PG8_BAR; PG8_MMA(1, 0, At, B0); PG8_MMA(1, 1, At, B1); PG8_BAR; PG8_SCHED;
            PG8_LDB(B0, 1, 0); PG8_LDB(B1, 1, 1); PG8_SCHED; PG8_LDA(At, 1, 0); PG8_STAGE(PG8_SA(0, 1), a2 + hstep, voffA);
            PG8_WAIT_V(8); PG8_WAIT_L(0); PG8_BAR; PG8_MMA(0, 0, At, B0); PG8_MMA(0, 1, At, B1); PG8_BAR; PG8_SCHED;
            PG8_LDA(At, 1, 1); PG8_STAGE(PG8_SB(1, 0), b3, voffB); PG8_STAGE(PG8_SB(1, 1), b3 + hstep, voffB); PG8_STAGE(PG8_SA(1, 0), a3, voffA);
            PG8_WAIT_V(8); PG8_WAIT_L(0); PG8_BAR; PG8_MMA(1, 0, At, B0); PG8_MMA(1, 1, At, B1); PG8_BAR; PG8_SCHED;
            } else {
            PG8_LDB(B0, 0, 0); PG8_SCHED; PG8_LDA(At, 0, 0); PG8_STAGE(PG8_SA(1, 1), a1 + hstep, voffA);
            PG8_WAIT_L(8); PG8_BAR; PG8_WAIT_L(0); PG8_MMA(0, 0, At, B0); PG8_BAR; PG8_SCHED;
            PG8_LDB(B1, 0, 1); PG8_STAGE(PG8_SB(0, 0), b2, voffB);
            PG8_BAR; PG8_WAIT_L(0); PG8_MMA(0, 1, At, B1); PG8_BAR;
            PG8_LDA(At, 0, 1); PG8_STAGE(PG8_SA(0, 0), a2, voffA);
            PG8_BAR; PG8_WAIT_L(0); PG8_MMA(1, 0, At, B0); PG8_BAR; PG8_SCHED;
            PG8_STAGE(PG8_SB(0, 1), b2 + hstep, voffB);
            PG8_WAIT_V(6); PG8_BAR; PG8_MMA(1, 1, At, B1); PG8_BAR;
            PG8_LDB(B0, 1, 0); PG8_SCHED; PG8_LDA(At, 1, 0); PG8_STAGE(PG8_SA(0, 1), a2 + hstep, voffA);
            PG8_WAIT_L(8); PG8_BAR; PG8_WAIT_L(0); PG8_MMA(0, 0, At, B0); PG8_BAR; PG8_SCHED;
            PG8_LDB(B1, 1, 1); PG8_STAGE(PG8_SB(1, 0), b3, voffB);
            PG8_BAR; PG8_WAIT_L(0); PG8_MMA(0, 1, At, B1); PG8_BAR;
            PG8_LDA(At, 1, 1); PG8_STAGE(PG8_SA(1, 0), a3, voffA);
            PG8_BAR; PG8_WAIT_L(0); PG8_MMA(1, 0, At, B0); PG8_BAR; PG8_SCHED;
            PG8_STAGE(PG8_SB(1, 1), b3 + hstep, voffB);
            PG8_WAIT_V(6); PG8_BAR; PG8_MMA(1, 1, At, B1); PG8_BAR;
            }
        }
        if constexpr (ALIGN_EPI) { if (wr == 0) PG8_BAR; }
        if constexpr (!Epi::AFTER_DRAIN) { E(acc, cur, wr, wc, fr, fq); S.done(cur); }
        if (!has_next) break;
#pragma unroll
        for (int a = 0; a < 2; ++a)
#pragma unroll
            for (int b = 0; b < 2; ++b)
#pragma unroll
                for (int m = 0; m < 4; ++m)
#pragma unroll
                    for (int n = 0; n < 2; ++n) acc[a][b][m][n] = (f32x4){0.f, 0.f, 0.f, 0.f};
        cur = nxt; cA = nA; cB = nB; ++ui;
        if constexpr (ALIGN_EPI) { if (wr == 1) PG8_BAR; }
    }
    PG8_WAIT_V(0);
    if constexpr (!ALIGN_EPI) { if (wr == 0) PG8_BAR; }
    PG8_BAR;
    if constexpr (Epi::AFTER_DRAIN) { E.fused(acc, cur, wr, wc, fr, fq, lds, wid, lane); S.done(cur); }
#undef PG8_SA
#undef PG8_SB
#undef PG8_STAGE
#undef PG8_LDA
#undef PG8_LDB
#undef PG8_MMA
#undef PG8_WAIT_V
#undef PG8_WAIT_L
#undef PG8_BAR
#undef PG8_SCHED
}
}
#define GAS __attribute__((address_space(1)))
#define LAS __attribute__((address_space(3)))
typedef unsigned short bf16;
typedef unsigned v4u __attribute__((ext_vector_type(4)));
typedef float f32x4 __attribute__((ext_vector_type(4)));
typedef short bf16x8 __attribute__((ext_vector_type(8)));
typedef GAS unsigned gu32;
typedef GAS unsigned long long gu64;
#define RLX_AGENT __ATOMIC_RELAXED, __HIP_MEMORY_SCOPE_AGENT
#define LDS_WAIT() asm volatile("s_waitcnt lgkmcnt(0)" ::: "memory")
#define VM_WAIT() asm volatile("s_waitcnt vmcnt(0)" ::: "memory")
__device__ __forceinline__ unsigned long long rt() { return __builtin_amdgcn_s_memrealtime(); }
__device__ __forceinline__ unsigned f2bf(float f) { unsigned u = __builtin_bit_cast(unsigned, f); return (u + 0x7fffu + ((u >> 16) & 1u)) >> 16; }
__device__ __forceinline__ unsigned pk2(float lo, float hi) { return f2bf(lo) | (f2bf(hi) << 16); }

#define XB_TMO      128
#define XB_XCNT(j)  (256  + 64 * (j))
#define XB_XSUB(j)  (1280 + 64 * (j))
#define XB_XGEN(j)  (2304 + 64 * (j))
#define XB_TOP      3328
#define XB_TOPGEN   3392
#define XCD_BAR_WORDS 3456
#define XB_SPIN_CAP (1u << 18)

__device__ __forceinline__ unsigned xb_ld(unsigned* p)              { return __hip_atomic_load(p, __ATOMIC_RELAXED, __HIP_MEMORY_SCOPE_AGENT); }
__device__ __forceinline__ unsigned xb_add(unsigned* p, unsigned v) { return __hip_atomic_fetch_add(p, v, __ATOMIC_RELAXED, __HIP_MEMORY_SCOPE_AGENT); }
__device__ __forceinline__ unsigned xb_xcc_id() { return (unsigned)__builtin_amdgcn_s_getreg((3 << 11) | 20) & 0xFu; }
#define XB_SPIN(cond, bar) do { unsigned _sp = 0; while (cond) { __builtin_amdgcn_s_sleep(1); \
    if ((++_sp & 255u) == 0u) { if (xb_ld(&(bar)[XB_TMO])) break; if (_sp > XB_SPIN_CAP) { atomicAdd(&(bar)[XB_TMO], 1u); break; } } } } while (0)

struct XcdBarrier {
    unsigned* bar; unsigned x;
    volatile LAS unsigned* st;
};

__device__ __forceinline__ XcdBarrier xcd_barrier_post(unsigned* bar, volatile LAS unsigned* st) {
    XcdBarrier b; b.bar = bar; b.x = xb_xcc_id(); b.st = st;
    if (threadIdx.x == 0) (void)xb_add(&bar[XB_XCNT(b.x)], 1u);
    return b;
}
__device__ __forceinline__ void xcd_barrier_complete(unsigned* bar, unsigned x, unsigned& nloc, unsigned& nx) {
    const unsigned G = gridDim.x * gridDim.y * gridDim.z;
    unsigned sum, cnt, mine, sp = 0u;
    for (;;) {
        sum = 0u; cnt = 0u; mine = 0u;
#pragma unroll
        for (unsigned j = 0; j < 16; ++j) { const unsigned c = xb_ld(&bar[XB_XCNT(j)]); sum += c; cnt += (c > 0u) ? 1u : 0u; mine = (j == x) ? c : mine; }
        if (sum == G) break;
        __builtin_amdgcn_s_sleep(1);
        if ((++sp & 255u) == 0u) { if (xb_ld(&bar[XB_TMO])) break; if (sp > XB_SPIN_CAP) { atomicAdd(&bar[XB_TMO], 1u); break; } }
    }
    nloc = mine > 0u ? mine : 1u; nx = cnt > 0u ? cnt : 1u;
}

__device__ __forceinline__ void xcd_barrier(const XcdBarrier& b) {
    asm volatile("s_waitcnt vmcnt(0)" ::: "memory");
    __syncthreads();
    if (threadIdx.x == 0) {
        unsigned* bar = b.bar;
        __builtin_amdgcn_s_waitcnt(0);
        unsigned nloc = b.st[0], nx = b.st[1];
        if (nloc == 0u) { xcd_barrier_complete(bar, b.x, nloc, nx); b.st[0] = nloc; b.st[1] = nx; }
        const unsigned old = xb_add(&bar[XB_XSUB(b.x)], 1u);
        const unsigned gen = old / nloc;
        if (old + 1u == (gen + 1u) * nloc) {
            __builtin_amdgcn_fence(__ATOMIC_RELEASE, "agent");
            asm volatile("s_waitcnt vmcnt(0)" ::: "memory");
            const unsigned og = xb_add(&bar[XB_TOP], 1u);
            const unsigned tg = og / nx;
            if (og + 1u == (tg + 1u) * nx) xb_add(&bar[XB_TOPGEN], 1u);
            else XB_SPIN(xb_ld(&bar[XB_TOPGEN]) == tg, bar);
            __builtin_amdgcn_fence(__ATOMIC_ACQUIRE, "agent");
            xb_add(&bar[XB_XGEN(b.x)], 1u);
            asm volatile("s_waitcnt vmcnt(0)" ::: "memory");
        } else {
            XB_SPIN(xb_ld(&bar[XB_XGEN(b.x)]) == gen, bar);
            __builtin_amdgcn_fence(__ATOMIC_ACQUIRE, "agent");
            asm volatile("s_waitcnt vmcnt(0)" ::: "memory");
        }
    }
    __syncthreads();
}


constexpr int NWAVES = 8;
constexpr int BATCH = 8, SEQ = 2048, D = 1024, M = BATCH * SEQ, FF = 2816, NLAYER = 4, NH = 8;
constexpr int QL = 512, KVL = 256, QKD = 192;
constexpr float EPS = 1e-6f;

constexpr size_t MiB = 1u << 20;
constexpr size_t WS_CTL = 0, CTL_ZERO_BYTES = 1 * MiB;
constexpr size_t WS_COSA = 1 * MiB, WS_SINA = WS_COSA + 512 * 1024, WS_COSR = 2 * MiB, WS_SINR = WS_COSR + 256 * 1024, WS_KMEAN = 3 * MiB;
constexpr size_t FFN_W_BYTES = 16 * MiB + 512 * 1024, UP_W_BYTES = 11 * MiB;
__host__ __device__ constexpr size_t ws_wffn(int l, int s) { return (l < 2 ? 4 * MiB + (size_t)(l * 2 + s) * FFN_W_BYTES : 86 * MiB + (size_t)((l - 2) * 2 + s) * FFN_W_BYTES); }
__host__ __device__ constexpr size_t ws_wmoba(int l) { return 70 * MiB + (size_t)l * 8 * MiB; }
__host__ __device__ constexpr size_t ws_wmla(int j) { return 152 * MiB + (size_t)j * (4 * MiB + 512 * 1024); }
constexpr size_t WS_WDKV = 161 * MiB, WS_WUKV = 162 * MiB;
constexpr size_t WS_KN = 4 * MiB, WS_VS = 36 * MiB, WS_KR = 68 * MiB;
constexpr size_t WS_XN = 163 * MiB, WS_Y = 195 * MiB, WS_BIG = 227 * MiB, WS_O = 323 * MiB, WS_END = 355 * MiB;
constexpr size_t WS_RS = 3 * MiB + 512 * 1024;
constexpr int CW_TMO = 0, CW_CODE = 1, CW_BAR = 4096;

constexpr int RING_OFF = 0, RING_BYTES = 131072;
constexpr int LDSCTL_OFF = RING_BYTES, MISC_OFF = LDSCTL_OFF + 320;
constexpr int LDS_BYTES = 147456;

struct Frame {
    LAS unsigned char* lds;
    volatile LAS unsigned* MISC;
    gu32* ctl;
    int tid, lane, wave;
    int vcu, G, bx;
};
__device__ __forceinline__ Frame mk_frame(LAS unsigned char* lds, unsigned char* ws) {
    Frame F; int tid = threadIdx.x; asm volatile("" : "+v"(tid)); int bx = blockIdx.x; asm volatile("" : "+s"(bx)); int G = gridDim.x; asm volatile("" : "+s"(G));
    F.lds = lds; F.MISC = (volatile LAS unsigned*)(lds + MISC_OFF); F.ctl = (gu32*)(ws + WS_CTL);
    F.tid = tid; F.lane = tid & 63; F.wave = __builtin_amdgcn_readfirstlane(tid >> 6);
    F.G = G; F.bx = bx; F.vcu = (G % 8 == 0) ? (bx % 8) * (G / 8) + bx / 8 : bx;
    return F;
}

__device__ __forceinline__ float wave_sum(float v) {
#pragma unroll
    for (int o = 1; o < 64; o <<= 1) v += __shfl_xor(v, o);
    return v;
}
__device__ __forceinline__ float bf2f(unsigned short b) { return __builtin_bit_cast(float, ((unsigned)b) << 16); }

__device__ __forceinline__ void conv_item(const float* src, int ldw, const float* gain, bf16* dst  , int K, int k0, LAS float* scr, int lane) {
    if (src) {
#pragma unroll 8
        for (int i = 0; i < 32; ++i) { const int kk = 2 * i + (lane >> 5); float v = src[(size_t)(k0 + kk) * ldw + (lane & 31)]; if (gain) v *= gain[k0 + kk]; scr[kk * 33 + (lane & 31)] = v; }
    } else {
#pragma unroll 8
        for (int i = 0; i < 32; ++i) { const int kk = 2 * i + (lane >> 5); scr[kk * 33 + (lane & 31)] = 0.f; }
    }
    LDS_WAIT(); asm volatile("" ::: "memory");
    const int c = lane & 7;
#pragma unroll
    for (int j = 0; j < 4; ++j) { const int n = (lane >> 3) + 8 * j; const LAS float* s = scr + (8 * c) * 33 + n;
        v4u o; o.x = pk2(s[0 * 33], s[1 * 33]); o.y = pk2(s[2 * 33], s[3 * 33]); o.z = pk2(s[4 * 33], s[5 * 33]); o.w = pk2(s[6 * 33], s[7 * 33]);
        *(GAS v4u*)(dst + (size_t)n * K + k0 + 8 * c) = o; }
    LDS_WAIT(); asm volatile("" ::: "memory");
}

struct Inputs { const float *x, *gains, *w1, *w3, *w2, *wqkv, *wo_a, *wdq, *qnorm, *wuq, *wo_b, *kvin, *wdkv, *kvnorm, *wukv; };

__device__ __forceinline__ void prologue_weights(Frame& F, const Inputs& I, unsigned char* ws) {
    LAS float* scr = (LAS float*)(F.lds + RING_OFF + F.wave * 16384);
    const int gw = F.vcu * NWAVES + F.wave, NGW = F.G * NWAVES;
    constexpr int I_UP = 176 * 16, I_DN = 32 * 44, I_QKV = 96 * 16, I_WO = 32 * 16, I_DQ = 16 * 16, I_UQ = 48 * 8, I_DKV = 16 * 16, I_UKV = 64 * 4;
    constexpr int T_UP = 8 * I_UP, T_DN = 8 * I_DN, T_QKV = 2 * I_QKV, T_WOA = 2 * I_WO, T_DQ = 2 * I_DQ, T_UQ = 2 * I_UQ, T_WOB = 2 * I_WO;
    constexpr int NITEMS = T_UP + T_DN + T_QKV + T_WOA + T_DQ + T_UQ + T_WOB + I_DKV + I_UKV;
    for (int it = gw; it < NITEMS; it += NGW) {
        int r = it;
        if (r < T_UP) { const int ls = r / I_UP, q = r % I_UP, g = q >> 4, k0 = (q & 15) * 64, n0 = g * 32, pn = n0 >> 8, c0 = n0 & 255, bj = c0 >> 7, cw0 = c0 & 127, l = ls >> 1, s = ls & 1;
            const float* src = (bj ? I.w3 : I.w1) + (size_t)ls * D * FF + pn * 128 + cw0;
            conv_item(src, FF, I.gains + (l * 6 + (s ? 4 : 0)) * D, (bf16*)(ws + ws_wffn(l, s)) + (size_t)n0 * D, D, k0, scr, F.lane); continue; } r -= T_UP;
        if (r < T_DN) { const int ls = r / I_DN, q = r % I_DN, g = q / 44, k0 = (q % 44) * 64, n0 = g * 32, l = ls >> 1, s = ls & 1;
            conv_item(I.w2 + (size_t)ls * FF * D + n0, D, nullptr, (bf16*)(ws + ws_wffn(l, s) + UP_W_BYTES) + (size_t)n0 * FF, FF, k0, scr, F.lane); continue; } r -= T_DN;
        if (r < T_QKV) { const int l = r / I_QKV, q = r % I_QKV, g = q >> 4, k0 = (q & 15) * 64, n0 = g * 32, pn = n0 >> 8, which = pn >> 2, hp = pn & 3, c0 = n0 & 255, bj = c0 >> 7, cw0 = c0 & 127;
            const int head = 2 * hp + (cw0 >> 6), d = (cw0 & 63) + 64 * bj, sc = which * 1024 + head * 128 + d;
            conv_item(I.wqkv + (size_t)l * D * 3072 + sc, 3072, I.gains + (l * 6 + 2) * D, (bf16*)(ws + ws_wmoba(l)) + (size_t)n0 * D, D, k0, scr, F.lane); continue; } r -= T_QKV;
        if (r < T_WOA) { const int l = r / I_WO, q = r % I_WO, g = q >> 4, k0 = (q & 15) * 64, n0 = g * 32;
            conv_item(I.wo_a + (size_t)l * D * D + n0, D, nullptr, (bf16*)(ws + ws_wmoba(l) + 6 * MiB) + (size_t)n0 * D, D, k0, scr, F.lane); continue; } r -= T_WOA;
        if (r < T_DQ) { const int j = r / I_DQ, q = r % I_DQ, g = q >> 4, k0 = (q & 15) * 64, n0 = g * 32;
            conv_item(I.wdq + (size_t)j * D * QL + n0, QL, I.gains + ((2 + j) * 6 + 2) * D, (bf16*)(ws + ws_wmla(j)) + (size_t)n0 * D, D, k0, scr, F.lane); continue; } r -= T_DQ;
        if (r < T_UQ) { const int j = r / I_UQ, q = r % I_UQ, g = q >> 3, k0 = (q & 7) * 64, n0 = g * 32, pn = n0 >> 8, c0 = n0 & 255, bj = c0 >> 7, cw0 = c0 & 127;
            int sc; if (pn < 4) sc = (2 * pn + bj) * QKD + cw0; else sc = (4 * (pn - 4) + (cw0 >> 5)) * QKD + 128 + (cw0 & 31) + 32 * bj;
            conv_item(I.wuq + (size_t)j * QL * 1536 + sc, 1536, I.qnorm + j * QL, (bf16*)(ws + ws_wmla(j) + 1 * MiB) + (size_t)n0 * QL, QL, k0, scr, F.lane); continue; } r -= T_UQ;
        if (r < T_WOB) { const int j = r / I_WO, q = r % I_WO, g = q >> 4, k0 = (q & 15) * 64, n0 = g * 32;
            conv_item(I.wo_b + (size_t)j * D * D + n0, D, nullptr, (bf16*)(ws + ws_wmla(j) + 2 * MiB + 512 * 1024) + (size_t)n0 * D, D, k0, scr, F.lane); continue; } r -= T_WOB;
        if (r < I_DKV) { const int g = r >> 4, k0 = (r & 15) * 64, n0 = g * 32;
            conv_item(n0 < 320 ? I.wdkv + n0 : nullptr, 320, I.kvin, (bf16*)(ws + WS_WDKV) + (size_t)n0 * D, D, k0, scr, F.lane); continue; } r -= I_DKV;
        { const int g = r >> 2, k0 = (r & 3) * 64, n0 = g * 32;
            conv_item(I.wukv + n0, 2048, I.kvnorm, (bf16*)(ws + WS_WUKV) + (size_t)n0 * KVL, KVL, k0, scr, F.lane); }
    }
    const int gt = (F.vcu * NWAVES + F.wave) * 64 + F.lane, NGT = NGW * 64;
    for (int e = gt; e < SEQ * 96; e += NGT) {
        const int s = e / 96, i = e % 96; const bool A = i < 64; const int ii = A ? i : i - 64;
        const float expo = A ? (float)(2 * ii) / 128.0f : (float)(2 * ii) / 64.0f;
        const float inv = 1.0f / __builtin_exp2f(expo * 13.287712379549449f);
        const float ang = (float)s * inv;
        double rev = (double)ang * 0.15915494309189535; rev -= __builtin_floor(rev);
        const float rv = (float)rev, c = __builtin_amdgcn_cosf(rv), sn = __builtin_amdgcn_sinf(rv);
        if (A) { ((float*)(ws + WS_COSA))[s * 64 + ii] = c; ((float*)(ws + WS_SINA))[s * 64 + ii] = sn; }
        else { ((float*)(ws + WS_COSR))[s * 32 + ii] = c; ((float*)(ws + WS_SINR))[s * 32 + ii] = sn; }
    }
}

__device__ __forceinline__ void unpack8(const v4u w, float (&f)[8]) {
    f[0] = bf2f(w.x & 0xffff); f[1] = bf2f(w.x >> 16); f[2] = bf2f(w.y & 0xffff); f[3] = bf2f(w.y >> 16); f[4] = bf2f(w.z & 0xffff); f[5] = bf2f(w.z >> 16); f[6] = bf2f(w.w & 0xffff); f[7] = bf2f(w.w >> 16); }
__device__ __forceinline__ void pass_first(Frame& F, const float* xin, bf16* XB, float* RS) {
    const int gw = F.vcu * NWAVES + F.wave, NGW = F.G * NWAVES;
    for (int m = gw; m < M; m += NGW) {
        const GAS f32x4* xr = (const GAS f32x4*)(xin + (size_t)m * D) + F.lane;
        f32x4 v[4]; float s2 = 0.f;
#pragma unroll
        for (int j = 0; j < 4; ++j) v[j] = xr[64 * j];
#pragma unroll
        for (int j = 0; j < 4; ++j) s2 += (v[j].x * v[j].x + v[j].y * v[j].y) + (v[j].z * v[j].z + v[j].w * v[j].w);
        const float rstd = __builtin_amdgcn_rsqf(wave_sum(s2) * (1.f / D) + EPS);
        GAS unsigned long long* o8 = (GAS unsigned long long*)(XB + (size_t)m * D) + F.lane;
#pragma unroll
        for (int j = 0; j < 4; ++j) o8[64 * j] = (unsigned long long)pk2(v[j].x, v[j].y) | ((unsigned long long)pk2(v[j].z, v[j].w) << 32);
        if (F.lane == 0) RS[m] = rstd;
    }
}
template <bool LAST>
__device__ __forceinline__ void pass_norm(Frame& F, bf16* XB, const bf16* Y, const float* gpost, float wgt, float* RS, float* xout) {
    const int gw = F.vcu * NWAVES + F.wave, NGW = F.G * NWAVES;
    f32x4 g[2][2];
#pragma unroll
    for (int j = 0; j < 2; ++j) { g[j][0] = *((const GAS f32x4*)(gpost + 512 * j + 8 * F.lane)); g[j][1] = *((const GAS f32x4*)(gpost + 512 * j + 8 * F.lane + 4)); }
    for (int m0 = 2 * gw; m0 < M; m0 += 2 * NGW) {
        v4u xw[2][2], yw[2][2];
#pragma unroll
        for (int r = 0; r < 2; ++r)
#pragma unroll
            for (int j = 0; j < 2; ++j) { xw[r][j] = *((const GAS v4u*)(XB + (size_t)(m0 + r) * D + 512 * j) + F.lane); yw[r][j] = *((const GAS v4u*)(Y + (size_t)(m0 + r) * D + 512 * j) + F.lane); }
#pragma unroll
        for (int r = 0; r < 2; ++r) {
            float x[2][8], y[2][8]; float ss = 0.f;
#pragma unroll
            for (int j = 0; j < 2; ++j) { unpack8(xw[r][j], x[j]); unpack8(yw[r][j], y[j]);
#pragma unroll
                for (int e = 0; e < 8; ++e) ss += y[j][e] * y[j][e]; }
            const float rsy = wgt * __builtin_amdgcn_rsqf(wave_sum(ss) * (1.f / D) + EPS); float s2 = 0.f;
#pragma unroll
            for (int j = 0; j < 2; ++j)
#pragma unroll
                for (int e = 0; e < 8; ++e) { x[j][e] += y[j][e] * g[j][e >> 2][e & 3] * rsy; s2 += x[j][e] * x[j][e]; }
            if constexpr (LAST) {
#pragma unroll
                for (int j = 0; j < 2; ++j) { GAS f32x4* o = (GAS f32x4*)(xout + (size_t)(m0 + r) * D + 512 * j + 8 * F.lane);
                    o[0] = (f32x4){x[j][0], x[j][1], x[j][2], x[j][3]}; o[1] = (f32x4){x[j][4], x[j][5], x[j][6], x[j][7]}; }
            } else {
                const float rstd = __builtin_amdgcn_rsqf(wave_sum(s2) * (1.f / D) + EPS);
#pragma unroll
                for (int j = 0; j < 2; ++j) { v4u o; o.x = pk2(x[j][0], x[j][1]); o.y = pk2(x[j][2], x[j][3]); o.z = pk2(x[j][4], x[j][5]); o.w = pk2(x[j][6], x[j][7]);
                    *((GAS v4u*)(XB + (size_t)(m0 + r) * D + 512 * j) + F.lane) = o; }
                if (F.lane == 0) RS[m0 + r] = rstd;
            }
        }
    }
}
__device__ __forceinline__ void pass_cqnorm(Frame& F, bf16* CQ) {
    const int gw = F.vcu * NWAVES + F.wave, NGW = F.G * NWAVES;
    for (int m = gw; m < M; m += NGW) {
        GAS v4u* p = (GAS v4u*)(CQ + (size_t)m * QL) + F.lane; const v4u w = *p; float f[8];
        f[0] = bf2f(w.x & 0xffff); f[1] = bf2f(w.x >> 16); f[2] = bf2f(w.y & 0xffff); f[3] = bf2f(w.y >> 16); f[4] = bf2f(w.z & 0xffff); f[5] = bf2f(w.z >> 16); f[6] = bf2f(w.w & 0xffff); f[7] = bf2f(w.w >> 16);
        float ss = 0.f;
#pragma unroll
        for (int j = 0; j < 8; ++j) ss += f[j] * f[j];
        const float rstd = __builtin_amdgcn_rsqf(wave_sum(ss) * (1.f / QL) + EPS);
        v4u o; o.x = pk2(f[0] * rstd, f[1] * rstd); o.y = pk2(f[2] * rstd, f[3] * rstd); o.z = pk2(f[4] * rstd, f[5] * rstd); o.w = pk2(f[6] * rstd, f[7] * rstd);
        *p = o;
    }
}
__device__ __forceinline__ void pass_ckr(Frame& F, const bf16* CKR, bf16* CKV, bf16* KR, const float* cosR, const float* sinR) {
    const int gw = F.vcu * NWAVES + F.wave, NGW = F.G * NWAVES;
    for (int m = gw; m < M; m += NGW) {
        const int s = m & 2047;
        float f[4]; { const unsigned long long w = *((const GAS unsigned long long*)(CKR + (size_t)m * 512) + F.lane);
            f[0] = bf2f((unsigned short)(w & 0xffff)); f[1] = bf2f((unsigned short)((w >> 16) & 0xffff)); f[2] = bf2f((unsigned short)((w >> 32) & 0xffff)); f[3] = bf2f((unsigned short)(w >> 48)); }
        const float ss = (f[0] * f[0] + f[1] * f[1]) + (f[2] * f[2] + f[3] * f[3]);
        const float rstd = __builtin_amdgcn_rsqf(wave_sum(ss) * (1.f / KVL) + EPS);
        *((GAS unsigned long long*)(CKV + (size_t)m * KVL) + F.lane) = (unsigned long long)pk2(f[0] * rstd, f[1] * rstd) | ((unsigned long long)pk2(f[2] * rstd, f[3] * rstd) << 32);
        if (F.lane < 32) { const float x1 = bf2f(CKR[(size_t)m * 512 + 256 + F.lane]), x2 = bf2f(CKR[(size_t)m * 512 + 288 + F.lane]); const float c = cosR[s * 32 + F.lane], sn = sinR[s * 32 + F.lane];
            KR[(size_t)m * 64 + F.lane] = (bf16)f2bf(x1 * c - x2 * sn); KR[(size_t)m * 64 + 32 + F.lane] = (bf16)f2bf(x1 * sn + x2 * c); }
    }
}
__device__ __forceinline__ void pass_kmean(Frame& F, const bf16* K, bf16* KM) {
    const int gw = F.vcu * NWAVES + F.wave, NGW = F.G * NWAVES;
    for (int it = gw; it < 64 * 8 * 4; it += NGW) {
        const int bhb = it >> 2, dg = it & 3, rg = F.lane >> 2, dc = (F.lane & 3) * 8;
        const bf16* base = K + ((size_t)bhb * 256) * 128 + dg * 32 + dc;
        float a[8] = {0.f, 0.f, 0.f, 0.f, 0.f, 0.f, 0.f, 0.f};
#pragma unroll 4
        for (int i = 0; i < 16; ++i) { const v4u w = *(const GAS v4u*)(base + (size_t)(rg + 16 * i) * 128);
            a[0] += bf2f(w.x & 0xffff); a[1] += bf2f(w.x >> 16); a[2] += bf2f(w.y & 0xffff); a[3] += bf2f(w.y >> 16); a[4] += bf2f(w.z & 0xffff); a[5] += bf2f(w.z >> 16); a[6] += bf2f(w.w & 0xffff); a[7] += bf2f(w.w >> 16); }
#pragma unroll
        for (int j = 0; j < 8; ++j) { float v = a[j]; v += __shfl_xor(v, 4); v += __shfl_xor(v, 8); v += __shfl_xor(v, 16); v += __shfl_xor(v, 32); a[j] = v * (1.f / 256.f); }
        if (F.lane < 4) { unsigned hi[8], lo[8];
#pragma unroll
            for (int j = 0; j < 8; ++j) { hi[j] = f2bf(a[j]); lo[j] = f2bf(a[j] - bf2f((unsigned short)hi[j])); }
            bf16* d = KM + ((size_t)bhb * 2) * 128 + dg * 32 + dc;
            v4u o; o.x = hi[0] | (hi[1] << 16); o.y = hi[2] | (hi[3] << 16); o.z = hi[4] | (hi[5] << 16); o.w = hi[6] | (hi[7] << 16); *(GAS v4u*)d = o;
            o.x = lo[0] | (lo[1] << 16); o.y = lo[2] | (lo[3] << 16); o.z = lo[4] | (lo[5] << 16); o.w = lo[6] | (lo[7] << 16); *(GAS v4u*)(d + 128) = o; }
    }
}

namespace att {
typedef short s16x4 __attribute__((ext_vector_type(4)));
typedef float f32x16 __attribute__((ext_vector_type(16)));
typedef LAS char* lptr;
constexpr int SHM_V = 16384, SHM_K = 16384, SHM_KR = 8192;
constexpr int L_V = 0, L_K = SHM_V, L_KR = L_K + SHM_K, L_WS = L_KR + SHM_KR;
constexpr float THR = 8.f;
#define KSWZ(row, colB) ((row) * 256 + ((colB) ^ (((row) & 7) << 4)))
#define KRSWZ(row, colB) ((row) * 128 + ((colB) ^ (((row) & 7) << 4)))
#define SBAR() __builtin_amdgcn_sched_barrier(0)
__device__ __forceinline__ int v_st(int k, int c) { const int kk = (k & ~0xC) | ((k & 4) << 1) | ((k & 8) >> 1); return ((kk >> 3) * 4 + (c >> 5)) * 512 + ((kk & 7) * 32 + (c & 31)) * 2; }
__device__ __forceinline__ int v_rd_base(int lane) { return ((lane & 3) << 3) | (((lane >> 2) & 3) << 6) | (((lane >> 4) & 1) << 5) | (((lane >> 5) & 1) << 8); }
constexpr int v_rd_off(int d0, int ks, int half) { return d0 * 512 + ks * 4096 + half * 2048; }
__device__ __forceinline__ int crow(int r, int hi) { return (r & 3) + 8 * (r >> 2) + 4 * hi; }
__device__ __forceinline__ unsigned cvtpk(float lo, float hi) { unsigned r; asm volatile("v_cvt_pk_bf16_f32 %0, %1, %2" : "=v"(r) : "v"(lo), "v"(hi)); return r; }

__device__ __forceinline__ void mask_causal(f32x16& p0, f32x16& p1, int dq) {
    const float NEG = -__builtin_inff();
#pragma unroll
    for (int r = 0; r < 16; ++r) { const int c = (r & 3) + 8 * (r >> 2); if (dq - c < 0) p0[r] = NEG; if (dq - c - 32 < 0) p1[r] = NEG; }
}
__device__ __forceinline__ void partialSM(f32x16& p0, f32x16& p1, float& m_reg, float& mn, float& alpha, const float SCALE) {
    float pmax = p0[0];
#pragma unroll
    for (int r = 1; r < 16; ++r) pmax = fmaxf(pmax, p0[r]);
#pragma unroll
    for (int r = 0; r < 16; ++r) pmax = fmaxf(pmax, p1[r]);
    { auto rr = __builtin_amdgcn_permlane32_swap(__float_as_uint(pmax), __float_as_uint(pmax), false, false);
      pmax = fmaxf(__uint_as_float(rr[0]), __uint_as_float(rr[1])); }
    const float C2 = 1.4426950408889634f * SCALE;
    if (__builtin_expect(__all((pmax - m_reg) * SCALE <= THR), 1)) { mn = m_reg; alpha = 1.f; }
    else { mn = fmaxf(m_reg, pmax); alpha = __builtin_amdgcn_exp2f((m_reg - mn) * C2); m_reg = mn; }
    const float mnL = -mn * C2;
#pragma unroll
    for (int r = 0; r < 16; ++r) p0[r] = fmaf(p0[r], C2, mnL);
#pragma unroll
    for (int r = 0; r < 16; ++r) p1[r] = fmaf(p1[r], C2, mnL);
#pragma unroll
    for (int r = 0; r < 16; ++r) p0[r] = __builtin_amdgcn_exp2f(p0[r]);
}
__device__ __forceinline__ void finishSM(f32x16& p0, f32x16& p1, float alpha, float& l_reg, bf16x8& pa0, bf16x8& pa1, bf16x8& pa2, bf16x8& pa3) {
#pragma unroll
    for (int r = 0; r < 16; ++r) p1[r] = __builtin_amdgcn_exp2f(p1[r]);
    float ps = 0;
#pragma unroll
    for (int r = 0; r < 16; ++r) ps += p0[r];
#pragma unroll
    for (int r = 0; r < 16; ++r) ps += p1[r];
    { auto rr = __builtin_amdgcn_permlane32_swap(__float_as_uint(ps), __float_as_uint(ps), false, false);
      ps = __uint_as_float(rr[0]) + __uint_as_float(rr[1]); }
    l_reg = l_reg * alpha + ps;
#define PK4(P, B_, OUT) do { unsigned a0 = cvtpk(P[B_+0], P[B_+1]), a1 = cvtpk(P[B_+2], P[B_+3]);                          \
        unsigned b0 = cvtpk(P[B_+4], P[B_+5]), b1 = cvtpk(P[B_+6], P[B_+7]);                                             \
        auto r0 = __builtin_amdgcn_permlane32_swap(a0, b0, false, false); auto r1 = __builtin_amdgcn_permlane32_swap(a1, b1, false, false); \
        v4u w = {r0[0], r1[0], r0[1], r1[1]}; OUT = __builtin_bit_cast(bf16x8, w); } while (0)
    PK4(p0, 0, pa0); PK4(p0, 8, pa1); PK4(p1, 0, pa2); PK4(p1, 8, pa3);
#undef PK4
}
template <int ND0>
__device__ __forceinline__ void qkt(f32x16& p0, f32x16& p1, lptr K_lds, lptr KR_lds, int r32, int hi, const bf16x8* qr) {
    p0 = f32x16{}; p1 = f32x16{};
    lptr kb[4];
#pragma unroll
    for (int dd = 0; dd < 4; ++dd) kb[dd] = K_lds + KSWZ(r32, (dd * 16 + hi * 8) * 2);
#pragma unroll
    for (int d0 = 0; d0 < 8; ++d0) { lptr a = kb[d0 & 3] + (d0 >> 2) * 128;
        const bf16x8 b0 = *(const LAS bf16x8*)a, b1 = *(const LAS bf16x8*)(a + 32 * 256);
        p0 = __builtin_amdgcn_mfma_f32_32x32x16_bf16(b0, qr[d0], p0, 0, 0, 0);
        p1 = __builtin_amdgcn_mfma_f32_32x32x16_bf16(b1, qr[d0], p1, 0, 0, 0); }
    if constexpr (ND0 > 8) {
#pragma unroll
        for (int d0 = 8; d0 < ND0; ++d0) { lptr a = KR_lds + KRSWZ(r32, ((d0 - 8) * 2 + hi) * 16);
            const bf16x8 b0 = *(const LAS bf16x8*)a, b1 = *(const LAS bf16x8*)(a + 32 * 128);
            p0 = __builtin_amdgcn_mfma_f32_32x32x16_bf16(b0, qr[d0], p0, 0, 0, 0);
            p1 = __builtin_amdgcn_mfma_f32_32x32x16_bf16(b1, qr[d0], p1, 0, 0, 0); }
    }
}
__device__ __forceinline__ void pv_tile(f32x16* o, unsigned vb0, bf16x8 pa0, bf16x8 pa1, bf16x8 pa2, bf16x8 pa3) {
#define TRRD(dst, off) asm volatile("ds_read_b64_tr_b16 %0, %1 offset:%2" : "=&v"(dst) : "v"(vb0), "i"(off) : "memory")
#define PV_D0(d0) do { s16x4 l0, l1, l2, l3, h0, h1, h2, h3; constexpr int b_ = v_rd_off(d0, 0, 0); \
        TRRD(l0, b_); TRRD(h0, b_ + 2048); TRRD(l1, b_ + 4096); TRRD(h1, b_ + 6144); TRRD(l2, b_ + 8192); TRRD(h2, b_ + 10240); TRRD(l3, b_ + 12288); TRRD(h3, b_ + 14336); \
        asm volatile("s_waitcnt lgkmcnt(0)" ::: "memory"); SBAR();   \
        o[d0] = __builtin_amdgcn_mfma_f32_32x32x16_bf16(pa0, (bf16x8){l0[0], l0[1], l0[2], l0[3], h0[0], h0[1], h0[2], h0[3]}, o[d0], 0, 0, 0);   \
        o[d0] = __builtin_amdgcn_mfma_f32_32x32x16_bf16(pa1, (bf16x8){l1[0], l1[1], l1[2], l1[3], h1[0], h1[1], h1[2], h1[3]}, o[d0], 0, 0, 0);   \
        o[d0] = __builtin_amdgcn_mfma_f32_32x32x16_bf16(pa2, (bf16x8){l2[0], l2[1], l2[2], l2[3], h2[0], h2[1], h2[2], h2[3]}, o[d0], 0, 0, 0);   \
        o[d0] = __builtin_amdgcn_mfma_f32_32x32x16_bf16(pa3, (bf16x8){l3[0], l3[1], l3[2], l3[3], h3[0], h3[1], h3[2], h3[3]}, o[d0], 0, 0, 0); } while (0)
    PV_D0(0); PV_D0(1); PV_D0(2); PV_D0(3);
#undef PV_D0
#undef TRRD
}

template <bool MLA>
__device__ __forceinline__ void attn_block(const bf16* Qb, const bf16* Kn, const bf16* Kr, const bf16* Vv, bf16* Ob, const bf16* kmean, int qb, lptr lds) {
    constexpr int ND0 = MLA ? 12 : 8, QS = MLA ? 192 : 128;
    constexpr float SCALE = MLA ? 0.07216878364870322f : 0.08838834764831845f;
    int tid = threadIdx.x; asm volatile("" : "+v"(tid));
    const int wid = __builtin_amdgcn_readfirstlane(tid >> 6), lane = tid & 63, r32 = lane & 31, hi = lane >> 5;
    const int P0 = qb * 256, qlo = P0 + wid * 32, qm = qlo + r32 - 4 * hi;
    lptr V_lds = lds + L_V; lptr K_lds = lds + L_K; lptr KR_lds = lds + L_KR;
    LAS float* wsf = (LAS float*)(lds + L_WS) + wid * 64; LAS float* li_l = wsf; LAS float* al_l = wsf + 32;
    const int sr = tid >> 4, sc = (tid & 15) * 8, vst0 = v_st(sr, sc), vst1 = v_st(32 + sr, sc), kws = KSWZ(sr, sc * 2);
    const int krr = tid >> 3, krc = tid & 7, krws = KRSWZ(krr, krc * 16);
    const unsigned vb0 = (unsigned)(uintptr_t)V_lds + v_rd_base(lane);
    bf16x8 qr[ND0];
#pragma unroll
    for (int d0 = 0; d0 < ND0; ++d0) qr[d0] = *(const GAS bf16x8*)(Qb + (size_t)(wid * 32 + r32) * QS + d0 * 16 + hi * 8);
    unsigned sel = 0xffu;
    if constexpr (!MLA) {
        if (qb <= 3) sel = (1u << qb) - 1u;
        else {
            __syncthreads();
            if (tid < 256) { const int blk = tid >> 5, hl = (tid >> 4) & 1, ch = tid & 15;
                const bf16x8 w = *(const GAS bf16x8*)(kmean + ((blk * 2 + hl) * 128 + ch * 8));
                *(LAS bf16x8*)(K_lds + KSWZ(blk + 32 * hl, ch * 16)) = w; }
            __syncthreads();
            f32x16 g0, g1; qkt<8>(g0, g1, K_lds, KR_lds, r32, hi, qr);
            float gl[4], go[4], g[8];
#pragma unroll
            for (int j = 0; j < 4; ++j) { gl[j] = g0[j] + g1[j]; go[j] = __shfl_xor(gl[j], 32); }
#pragma unroll
            for (int j = 0; j < 4; ++j) { g[j] = hi ? go[j] : gl[j]; g[4 + j] = hi ? gl[j] : go[j]; }
            sel = 0u;
#pragma unroll
            for (int j = 0; j < 8; ++j) { int rank = 0;
#pragma unroll
                for (int i = 0; i < 8; ++i) if (i != j) rank += (i < qb && (g[i] > g[j] || (g[i] == g[j] && i < j))) ? 1 : 0;
                if (j < qb && rank < 3) sel |= 1u << j; }
        }
    }
    float m_reg = -1e30f, l_reg = 0.f; f32x16 o[4] = {};
    const int NT = 4 * (qb + 1);
    bf16x8 st_k0, st_k1, st_v0, st_v1, st_kr;
#define SLOAD(kb) do { st_k0 = *(const GAS bf16x8*)(Kn + (size_t)((kb) + sr) * 128 + sc); st_k1 = *(const GAS bf16x8*)(Kn + (size_t)((kb) + 32 + sr) * 128 + sc); \
                       st_v0 = *(const GAS bf16x8*)(Vv + (size_t)((kb) + sr) * 128 + sc); st_v1 = *(const GAS bf16x8*)(Vv + (size_t)((kb) + 32 + sr) * 128 + sc); \
                       if constexpr (MLA) st_kr = *(const GAS bf16x8*)(Kr + (size_t)((kb) + krr) * 64 + krc * 8); } while (0)
    SLOAD(0);
    for (int t = 0; t < NT; ++t) {
        const int kb = t * 64, j = t >> 2;
        __syncthreads();
        *(LAS bf16x8*)(K_lds + kws) = st_k0; *(LAS bf16x8*)(K_lds + kws + 32 * 256) = st_k1;
        *(LAS bf16x8*)(V_lds + vst0) = st_v0; *(LAS bf16x8*)(V_lds + vst1) = st_v1;
        if constexpr (MLA) *(LAS bf16x8*)(KR_lds + krws) = st_kr;
        if (t + 1 < NT) SLOAD(kb + 64);
        __syncthreads();
        bool act = kb <= qlo + 31;
        if constexpr (!MLA) { if (j < qb) act = __any((sel >> j) & 1u) != 0; }
        if (act) {
            f32x16 p0, p1; float mn, alpha; bf16x8 pa0, pa1, pa2, pa3;
            qkt<ND0>(p0, p1, K_lds, KR_lds, r32, hi, qr);
            if (j == qb) { if (kb + 63 > qlo) mask_causal(p0, p1, qm - kb); }
            else if constexpr (!MLA) { if (!((sel >> j) & 1u)) { const float NEG = -__builtin_inff();
#pragma unroll
                for (int r = 0; r < 16; ++r) { p0[r] = NEG; p1[r] = NEG; } } }
            partialSM(p0, p1, m_reg, mn, alpha, SCALE);
            if (__any(alpha < 1.f)) { if (hi == 0) al_l[r32] = alpha; asm volatile("s_waitcnt lgkmcnt(0)" ::: "memory");
#pragma unroll
                for (int d_ = 0; d_ < 4; ++d_)
#pragma unroll
                    for (int r = 0; r < 16; ++r) o[d_][r] *= al_l[crow(r, hi)]; }
            finishSM(p0, p1, alpha, l_reg, pa0, pa1, pa2, pa3); SBAR();
            pv_tile(o, vb0, pa0, pa1, pa2, pa3);
        }
    }
#undef SLOAD
    if (hi == 0) li_l[r32] = l_reg; asm volatile("s_waitcnt lgkmcnt(0)" ::: "memory");
    bf16* Ow = Ob + (size_t)(wid * 32) * D;
#pragma unroll
    for (int r = 0; r < 16; ++r) { const int orow = crow(r, hi); const float rl = __builtin_amdgcn_rcpf(li_l[orow]);
#pragma unroll
        for (int d0 = 0; d0 < 4; ++d0) { const float v = o[d0][r] * rl; const float vn = __shfl_xor(v, 1);
            if ((r32 & 1) == 0) *(GAS unsigned*)(Ow + (size_t)orow * D + d0 * 32 + r32) = cvtpk(v, vn); } }
}
#undef KSWZ
#undef KRSWZ
#undef SBAR
}

template <bool MLA>
__device__ __forceinline__ void attn_phase(Frame& F, const bf16* Q, const bf16* Kn, const bf16* Kr, const bf16* Vv, bf16* O, const bf16* KM) {
    constexpr int QS = MLA ? 192 : 128;
    for (int u = F.vcu; u < 256; u += F.G) {
        const int bh = u >> 2, pr = u & 3, b = bh >> 3, h = bh & 7;
#pragma unroll 1
        for (int pass = 0; pass < 2; ++pass) { const int qb = pass ? pr : 7 - pr;
            att::attn_block<MLA>(Q + ((size_t)bh * SEQ + qb * 256) * QS, Kn + (size_t)bh * SEQ * 128, Kr + (size_t)b * SEQ * 64, Vv + (size_t)bh * SEQ * 128,
                                 O + ((size_t)b * SEQ + qb * 256) * D + h * 128, KM + (size_t)bh * 8 * 2 * 128, qb, (att::lptr)(F.lds + RING_OFF)); }
    }
}

#ifndef REP_UP
#define REP_UP 1
#endif
#ifndef REP_DN
#define REP_DN 1
#endif
#ifndef REP_ATT
#define REP_ATT 1
#endif
#ifndef REP_OTH
#define REP_OTH 1
#endif
struct Args { const float* in[15]; float* out; unsigned char* ws; };
static_assert(sizeof(Args) == 136, "kernarg layout");
__global__ void __launch_bounds__(NWAVES * 64, 2) mk_fwd(Args args) {
    extern __shared__ __attribute__((aligned(16))) unsigned char lds[];
    LAS unsigned char* const L = (LAS unsigned char*)lds;
    (void)args;
#define KSEG() const __attribute__((address_space(4))) char* kseg_ = (const __attribute__((address_space(4))) char*)__builtin_amdgcn_kernarg_segment_ptr(); asm volatile("" : "+s"(kseg_))
#define KARG_IN(k) (*(const float* const __attribute__((address_space(4)))*)(kseg_ + 8 * (k)))
#define KARG_OUT() (*(float* const __attribute__((address_space(4)))*)(kseg_ + 8 * 15))
#define KARG_WS() (*(unsigned char* const __attribute__((address_space(4)))*)(kseg_ + 8 * 16))
    for (int u = threadIdx.x; u < (LDS_BYTES - LDSCTL_OFF) / 4; u += NWAVES * 64) ((LAS unsigned*)(L + LDSCTL_OFF))[u] = 0u;
    __syncthreads();
    { KSEG(); (void)xcd_barrier_post((unsigned*)((gu32*)(KARG_WS() + WS_CTL) + CW_BAR), (volatile LAS unsigned*)(L + MISC_OFF) + 8); }
#define GRID_BAR() do { KSEG(); unsigned char* wsb_ = KARG_WS(); unsigned stb_ = MISC_OFF + 32; asm volatile("" : "+s"(stb_)); XcdBarrier b_; \
        b_.bar = (unsigned*)(wsb_ + WS_CTL) + CW_BAR; b_.x = xb_xcc_id(); b_.st = (volatile LAS unsigned*)(L + stb_); xcd_barrier(b_); } while (0)
#define PHASE_BEGIN() KSEG(); unsigned char* ws = KARG_WS(); Frame F = mk_frame(L, ws); float* X = KARG_OUT(); \
    bf16* XN = (bf16*)(ws + WS_XN); bf16* Y = (bf16*)(ws + WS_Y); bf16* BIG = (bf16*)(ws + WS_BIG); (void)X; (void)XN; (void)Y; (void)BIG; (void)F

    { PHASE_BEGIN();
      Inputs I; I.x = KARG_IN(0); I.gains = KARG_IN(1); I.w1 = KARG_IN(2); I.w3 = KARG_IN(3); I.w2 = KARG_IN(4); I.wqkv = KARG_IN(5); I.wo_a = KARG_IN(6); I.wdq = KARG_IN(7); I.qnorm = KARG_IN(8);
      I.wuq = KARG_IN(9); I.wo_b = KARG_IN(10); I.kvin = KARG_IN(11); I.wdkv = KARG_IN(12); I.kvnorm = KARG_IN(13); I.wukv = KARG_IN(14);
      prologue_weights(F, I, ws);
      pass_first(F, I.x, XN, (float*)(ws + WS_RS)); }
    GRID_BAR();

#pragma unroll 1
    for (int hl = 0; hl < 2 * NLAYER; ++hl) {
        const int l = hl >> 1, s = hl & 1;
        { PHASE_BEGIN(); pg8::Gemm g{XN, (const bf16*)(ws + ws_wffn(l, s)), M, 2 * FF, D}; pg8::StaticOrder S; S.init(M, 2 * FF, F.G, F.bx);
          pg8::EpiSwiGLU E{BIG, FF, (const float*)(ws + WS_RS)};
          pg8::gemm_phase<pg8::EpiSwiGLU, pg8::StaticOrder, true, true>(F.lds + RING_OFF, g, S, E); }
        #if REP_UP > 1
        GRID_BAR();
        { PHASE_BEGIN(); pg8::Gemm g{XN, (const bf16*)(ws + ws_wffn(l, s)), M, 2 * FF, D}; pg8::StaticOrder S; S.init(M, 2 * FF, F.G, F.bx);
          pg8::EpiSwiGLU E{BIG, FF, (const float*)(ws + WS_RS)};
          pg8::gemm_phase<pg8::EpiSwiGLU, pg8::StaticOrder, true, true>(F.lds + RING_OFF, g, S, E); }
        #endif
        GRID_BAR();
        { PHASE_BEGIN(); pg8::Gemm g{BIG, (const bf16*)(ws + ws_wffn(l, s) + UP_W_BYTES), M, D, FF}; pg8::StaticOrder S; S.init(M, D, F.G, F.bx);
          pg8::EpiPlain E{Y, D, nullptr};
          pg8::gemm_phase<pg8::EpiPlain, pg8::StaticOrder, true, true>(F.lds + RING_OFF, g, S, E); }
        #if REP_DN > 1
        GRID_BAR();
        { PHASE_BEGIN(); pg8::Gemm g{BIG, (const bf16*)(ws + ws_wffn(l, s) + UP_W_BYTES), M, D, FF}; pg8::StaticOrder S; S.init(M, D, F.G, F.bx);
          pg8::EpiPlain E{Y, D, nullptr};
          pg8::gemm_phase<pg8::EpiPlain, pg8::StaticOrder, true, true>(F.lds + RING_OFF, g, S, E); }
        #endif
        GRID_BAR();
        if (hl < 2 * NLAYER - 1) { PHASE_BEGIN(); pass_norm<false>(F, XN, Y, KARG_IN(1) + (l * 6 + (s ? 5 : 1)) * D, 0.5f, (float*)(ws + WS_RS), X); }
        else { PHASE_BEGIN(); pass_norm<true>(F, XN, Y, KARG_IN(1) + (l * 6 + (s ? 5 : 1)) * D, 0.5f, (float*)(ws + WS_RS), X); }
        GRID_BAR();
        if (s == 0) {
            if (l < 2) {
                { PHASE_BEGIN(); bf16* Qh = BIG; bf16* Kh = BIG + (size_t)M * D; bf16* Vh = BIG + (size_t)2 * M * D;
                  pg8::Gemm g{XN, (const bf16*)(ws + ws_wmoba(l)), M, 3 * D, D}; pg8::StaticOrder S; S.init(M, 3 * D, F.G, F.bx);
                  pg8::EpiQKV E{Qh, (size_t)M * D, (const float*)(ws + WS_COSA), (const float*)(ws + WS_SINA), (const float*)(ws + WS_RS)}; (void)Kh; (void)Vh;
                  pg8::gemm_phase<pg8::EpiQKV, pg8::StaticOrder, true, true>(F.lds + RING_OFF, g, S, E); }
                GRID_BAR();
                { PHASE_BEGIN(); pass_kmean(F, BIG + (size_t)M * D, (bf16*)(ws + WS_KMEAN)); }
                GRID_BAR();
                { PHASE_BEGIN(); attn_phase<false>(F, BIG, BIG + (size_t)M * D, BIG + (size_t)M * D, BIG + (size_t)2 * M * D, (bf16*)(ws + WS_O), (const bf16*)(ws + WS_KMEAN)); }
                #if REP_ATT > 1
        GRID_BAR();
                { PHASE_BEGIN(); attn_phase<false>(F, BIG, BIG + (size_t)M * D, BIG + (size_t)M * D, BIG + (size_t)2 * M * D, (bf16*)(ws + WS_O), (const bf16*)(ws + WS_KMEAN)); }
                #endif
        GRID_BAR();
            } else {
                const int j = l - 2;
                { PHASE_BEGIN(); bf16* CQ = BIG + (size_t)M * 8 * QKD;
                  pg8::Gemm g{XN, (const bf16*)(ws + ws_wmla(j)), M, QL, D}; pg8::StaticOrder S; S.init(M, QL, F.G, F.bx);
                  pg8::EpiPlain E{CQ, QL, (const float*)(ws + WS_RS)};
                  pg8::gemm_phase<pg8::EpiPlain, pg8::StaticOrder, true, true>(F.lds + RING_OFF, g, S, E); }
                GRID_BAR();
                { PHASE_BEGIN(); pass_cqnorm(F, BIG + (size_t)M * 8 * QKD); }
                GRID_BAR();
                { PHASE_BEGIN(); bf16* CQ = BIG + (size_t)M * 8 * QKD;
                  pg8::Gemm g{CQ, (const bf16*)(ws + ws_wmla(j) + 1 * MiB), M, 1536, QL}; pg8::StaticOrder S; S.init(M, 1536, F.G, F.bx);
                  pg8::EpiUQ E{BIG, (const float*)(ws + WS_COSR), (const float*)(ws + WS_SINR)};
                  pg8::gemm_phase<pg8::EpiUQ, pg8::StaticOrder, true, true>(F.lds + RING_OFF, g, S, E); }
                GRID_BAR();
                { PHASE_BEGIN(); attn_phase<true>(F, BIG, (const bf16*)(ws + WS_KN), (const bf16*)(ws + WS_KR), (const bf16*)(ws + WS_VS), (bf16*)(ws + WS_O), (const bf16*)(ws + WS_KMEAN)); }
                #if REP_ATT > 1
        GRID_BAR();
                { PHASE_BEGIN(); attn_phase<true>(F, BIG, (const bf16*)(ws + WS_KN), (const bf16*)(ws + WS_KR), (const bf16*)(ws + WS_VS), (bf16*)(ws + WS_O), (const bf16*)(ws + WS_KMEAN)); }
                #endif
        GRID_BAR();
            }
            { PHASE_BEGIN(); const bf16* Wo = (l < 2) ? (const bf16*)(ws + ws_wmoba(l) + 6 * MiB) : (const bf16*)(ws + ws_wmla(l - 2) + 2 * MiB + 512 * 1024);
              pg8::Gemm g{(const bf16*)(ws + WS_O), Wo, M, D, D}; pg8::StaticOrder S; S.init(M, D, F.G, F.bx);
              pg8::EpiPlain E{Y, D, nullptr};
              pg8::gemm_phase<pg8::EpiPlain, pg8::StaticOrder, true, true>(F.lds + RING_OFF, g, S, E); }
            GRID_BAR();
            { PHASE_BEGIN(); pass_norm<false>(F, XN, Y, KARG_IN(1) + (l * 6 + 3) * D, 1.0f, (float*)(ws + WS_RS), X); }
            GRID_BAR();
        }
        if (hl == 3) {
            { PHASE_BEGIN(); pg8::Gemm g{XN, (const bf16*)(ws + WS_WDKV), M, 512, D}; pg8::StaticOrder S; S.init(M, 512, F.G, F.bx);
              pg8::EpiPlain E{BIG, 512, (const float*)(ws + WS_RS)};
              pg8::gemm_phase<pg8::EpiPlain, pg8::StaticOrder, true, true>(F.lds + RING_OFF, g, S, E); }
            GRID_BAR();
            { PHASE_BEGIN(); pass_ckr(F, BIG, BIG + (size_t)M * 512, (bf16*)(ws + WS_KR), (const float*)(ws + WS_COSR), (const float*)(ws + WS_SINR)); }
            GRID_BAR();
            { PHASE_BEGIN(); pg8::Gemm g{BIG + (size_t)M * 512, (const bf16*)(ws + WS_WUKV), M, 2048, KVL}; pg8::StaticOrder S; S.init(M, 2048, F.G, F.bx);
              pg8::EpiUKV E{(bf16*)(ws + WS_KN), (bf16*)(ws + WS_VS)};
              pg8::gemm_phase<pg8::EpiUKV, pg8::StaticOrder, true, true>(F.lds + RING_OFF, g, S, E); }
            GRID_BAR();
        }
    }
#undef GRID_BAR
#undef PHASE_BEGIN
#undef KSEG
#undef KARG_IN
#undef KARG_OUT
#undef KARG_WS
}

extern "C" void kernel_launch(void* const* d_in, const int* in_sizes, int n_in, void* d_out, int out_size, void* d_ws, size_t ws_size, hipStream_t stream) {
    static int grid = 0;
    if (grid == 0) {
        if (n_in != 15 || in_sizes[0] != M * D || out_size != M * D || ws_size < WS_END) { fprintf(stderr, "kernel_launch: unexpected shapes (n_in %d, in0 %d, out %d, ws %zu); nothing launched\n", n_in, n_in > 0 ? in_sizes[0] : -1, out_size, ws_size); grid = -1; return; }
        int dev = 0, cus = 0, per_cu = 0;
        if (hipGetDevice(&dev) != hipSuccess || hipDeviceGetAttribute(&cus, hipDeviceAttributeMultiprocessorCount, dev) != hipSuccess) { grid = -1; return; }
        if (hipFuncSetAttribute((const void*)mk_fwd, hipFuncAttributeMaxDynamicSharedMemorySize, LDS_BYTES) != hipSuccess) { fprintf(stderr, "kernel_launch: hipFuncSetAttribute failed\n"); grid = -1; return; }
        if (hipOccupancyMaxActiveBlocksPerMultiprocessor(&per_cu, (const void*)mk_fwd, NWAVES * 64, LDS_BYTES) != hipSuccess || per_cu < 1) { fprintf(stderr, "kernel_launch: occupancy query reports %d workgroups per CU\n", per_cu); }
        (void)hipGetLastError();
        grid = cus;
    }
    if (grid < 0) return;
    if (hipMemsetAsync((char*)d_ws + WS_CTL, 0, CTL_ZERO_BYTES, stream) != hipSuccess) return;
    Args a{};
    for (int i = 0; i < 15; ++i) a.in[i] = (const float*)d_in[i];
    a.out = (float*)d_out; a.ws = (unsigned char*)d_ws;
    hipLaunchKernelGGL(mk_fwd, dim3(grid), dim3(NWAVES * 64), LDS_BYTES, stream, a);
}
```
